# Optimizing an MI355X kernel written in HIP

```python
import jax
import jax.numpy as jnp
from jax import lax
import numpy as np

D_MODEL = 1024
BATCH = 16
SEQ = 2048
DEPTH = 2

GRID_W = 64
CTX_LEN = 256
HEAD_DIM = 64
MIX_HEADS = 4
MIX_W = MIX_HEADS * HEAD_DIM
N_BRANCH = 4
RWKV_LORA_W = 64
RWKV_LORA_A = 64
RWKV_LORA_G = 128
RWKV_GN_EPS = HEAD_DIM * 1e-5
RET_CHUNK = 128
HGRN_CHUNK = 64
HGRN_LB_FLOOR = 1e-20
ATTN_KV_HEADS = 2
ATTN_BLOCK = 128
ROPE_BASE = 10000.0
N_EXPERTS = 16
D_EXPERT = 1024
EC_CAPACITY = 2
LN_EPS = 1e-5
RMS_EPS = 1e-6
DEEPNORM_ALPHA = (2 * DEPTH) ** 0.25
DEEPNORM_BETA = (8 * DEPTH) ** -0.25

RWKV_COLS = (MIX_W, MIX_W, MIX_W, 2 * RWKV_LORA_W, 2 * RWKV_LORA_A, RWKV_LORA_G)
RET_COLS = (MIX_W, MIX_W, MIX_W, MIX_W)
HGRN_COLS = (MIX_W, 2 * MIX_W, MIX_W, MIX_W)
ATTN_COLS = (MIX_W, ATTN_KV_HEADS * HEAD_DIM, ATTN_KV_HEADS * HEAD_DIM)
GROUP_COLS = (sum(RWKV_COLS), sum(RET_COLS), sum(HGRN_COLS), sum(ATTN_COLS))
D_IN = sum(GROUP_COLS)

kernel_name = 'hybrid_bidir_diffusion_block'


def split_cols(z, sizes):
    return jnp.split(z, [int(s) for s in np.cumsum(sizes)[:-1]], axis=-1)


def heads(t):
    return t.reshape(t.shape[:-1] + (-1, HEAD_DIM))


def merge_heads(t):
    return t.reshape(t.shape[:-2] + (-1,))


def layer_norm(x, g, b):
    xf = x.astype(jnp.float32)
    mu = jnp.mean(xf, -1, keepdims=True)
    var = jnp.mean(jnp.square(xf - mu), -1, keepdims=True)
    return ((xf - mu) * lax.rsqrt(var + LN_EPS)).astype(x.dtype) * g + b


def rms_norm(x, g):
    xf = x.astype(jnp.float32)
    return (xf * lax.rsqrt(jnp.mean(xf * xf, -1, keepdims=True) + RMS_EPS)).astype(x.dtype) * g


def group_norm(y, g, b, eps):
    yf = y.astype(jnp.float32)
    mu = jnp.mean(yf, -1, keepdims=True)
    var = jnp.mean(jnp.square(yf - mu), -1, keepdims=True)
    return merge_heads(((yf - mu) * lax.rsqrt(var + eps)).astype(y.dtype)) * g + b


def rev_segments(t, n_ctx):
    return jnp.concatenate([jnp.flip(t[:, :n_ctx], 1), jnp.flip(t[:, n_ctx:], 1)], axis=1)


def both_dirs(t):
    return jnp.stack([t, t])


def orient(t, n_ctx):
    return jnp.stack([t[0], rev_segments(t[1], n_ctx)])


def deorient_sum(y, n_ctx):
    return y[0] + rev_segments(y[1], n_ctx)


def centred_shift(t, n_ctx):
    def nb(s):
        p = jnp.pad(s, ((0, 0), (1, 1), (0, 0)))
        return 0.5 * (p[:, :-2] + p[:, 2:])
    return jnp.concatenate([nb(t[:, :n_ctx]), nb(t[:, n_ctx:])], axis=1)


def axial_rope_tables(n_tokens, dtype):
    rows = n_tokens // GRID_W
    row = jnp.repeat(jnp.arange(rows), GRID_W)
    col = jnp.tile(jnp.arange(GRID_W), rows)
    n_freq = HEAD_DIM // 4
    inv = ROPE_BASE ** (-jnp.arange(n_freq, dtype=jnp.float32) / n_freq)
    ang = jnp.concatenate([row[:, None] * inv, col[:, None] * inv], axis=-1)
    return jnp.cos(ang).astype(dtype), jnp.sin(ang).astype(dtype)


def apply_rope(x, cos, sin):
    x1, x2 = x[..., :HEAD_DIM // 2], x[..., HEAD_DIM // 2:]
    c, s = cos[:, None], sin[:, None]
    return jnp.concatenate([x1 * c - x2 * s, x1 * s + x2 * c], axis=-1)


def rope_latent(t, n_ctx, cos, sin):
    return jnp.concatenate([t[:, :n_ctx], apply_rope(t[:, n_ctx:], cos, sin)], axis=1)


def rwkv7_scan(r, w, k, v, kk, a):
    def step(S, inp):
        r_t, w_t, k_t, v_t, kk_t, a_t = inp
        s_kk = jnp.einsum('zbhvk,zbhk->zbhv', S, kk_t)
        S = (S * w_t[..., None, :] - s_kk[..., None] * (kk_t * a_t)[..., None, :]
             + v_t[..., None] * k_t[..., None, :]).astype(S.dtype)
        return S, jnp.einsum('zbhvk,zbhk->zbhv', S, r_t)
    nz, bsz, _, nh, n = r.shape
    S0 = jnp.zeros((nz, bsz, nh, n, n), v.dtype)
    _, ys = lax.scan(step, S0, tuple(jnp.moveaxis(t, 2, 0) for t in (r, w, k, v, kk, a)))
    return jnp.moveaxis(ys, 0, 2)


def rwkv7_mixer(z, n_ctx, lo, mu, w0, w2, a0, a2, g2, k_k, k_a, r_k, ln_g, ln_b):
    z = z + mu * (centred_shift(z, n_ctx) - z)
    r, k, v, zw, za, zg = split_cols(z, RWKV_COLS)
    bsz, n_tok, _ = z.shape
    zw = zw.reshape(bsz, n_tok, 2, RWKV_LORA_W)
    za = za.reshape(bsz, n_tok, 2, RWKV_LORA_A)
    w = w0[:, None, None] + jnp.einsum('btzr,zrc->zbtc', jnp.tanh(zw), w2)
    decay = jnp.exp(-jnp.exp(-jax.nn.softplus(-w) - 0.5))
    a = jax.nn.sigmoid(a0[:, None, None] + jnp.einsum('btzr,zrc->zbtc', za, a2))
    kkf = heads(k * k_k).astype(jnp.float32)
    kk = (kkf * lax.rsqrt(jnp.sum(kkf * kkf, -1, keepdims=True) + 1e-12)).astype(z.dtype)
    k_dir = k * (1 + (a - 1) * k_a)
    ys = rwkv7_scan(orient(both_dirs(heads(r)), n_ctx), orient(heads(decay), n_ctx), orient(heads(k_dir), n_ctx),
                    orient(both_dirs(heads(v)), n_ctx), orient(both_dirs(kk), n_ctx), orient(heads(a), n_ctx))
    y = group_norm(deorient_sum(ys, n_ctx)[:, lo:], ln_g, ln_b, RWKV_GN_EPS)
    rh, kh, vh = heads(r[:, lo:]), heads(k[:, lo:]), heads(v[:, lo:])
    bonus = merge_heads(jnp.sum(rh * kh * heads(r_k), -1, keepdims=True) * vh)
    g = jax.nn.sigmoid(zg[:, lo:]) @ g2
    return (y + bonus) * g


def retention_chunkwise(q, k, v, log_gamma, chunk=RET_CHUNK):
    nz, bsz, n_tok, nh, dk = q.shape
    dv = v.shape[-1]
    n_chunk = n_tok // chunk

    def blocks(t):
        return jnp.moveaxis(t.reshape(nz, bsz, n_chunk, chunk, nh, t.shape[-1]), 2, 0)
    pos = jnp.arange(chunk, dtype=jnp.float32)
    rel = pos[:, None] - pos[None, :]
    lg = log_gamma[:, :, None, None]
    intra = jnp.where(rel >= 0, jnp.exp(lg * jnp.maximum(rel, 0.0)), 0.0).astype(q.dtype)
    lgt = log_gamma[:, None, :]
    q_decay = jnp.exp(lgt * (pos[:, None] + 1.0))[:, None, :, :, None].astype(q.dtype)
    k_decay = jnp.exp(lgt * (chunk - 1.0 - pos[:, None]))[:, None, :, :, None].astype(q.dtype)
    chunk_decay = jnp.exp(log_gamma * chunk)[:, None, :, None, None].astype(v.dtype)

    def step(R, inp):
        qc, kc, vc = inp
        s = jnp.einsum('zbthd,zbshd->zbhts', qc, kc) * intra[:, None]
        o = jnp.einsum('zbhts,zbshe->zbthe', s, vc) + jnp.einsum('zbthd,zbhde->zbthe', qc * q_decay, R)
        R = (R * chunk_decay + jnp.einsum('zbshd,zbshe->zbhde', kc * k_decay, vc)).astype(R.dtype)
        return R, o
    R0 = jnp.zeros((nz, bsz, nh, dk, dv), v.dtype)
    _, o = lax.scan(step, R0, (blocks(q), blocks(k), blocks(v)))
    return jnp.moveaxis(o, 0, 2).reshape(nz, bsz, n_tok, nh, dv)


def retention_mixer(z, n_ctx, lo, cos, sin, decay_logit, norm_g, norm_b):
    q, k, v, g = split_cols(z, RET_COLS)
    q = rope_latent(heads(q), n_ctx, cos, sin)
    k = rope_latent(heads(k), n_ctx, cos, sin) * HEAD_DIM ** -0.5
    log_gamma = jax.nn.log_sigmoid(decay_logit.astype(jnp.float32))
    y = retention_chunkwise(orient(both_dirs(q), n_ctx), orient(both_dirs(k), n_ctx),
                            orient(both_dirs(heads(v)), n_ctx), log_gamma)
    y = deorient_sum(y, n_ctx)[:, lo:]
    return group_norm(y, norm_g, norm_b, LN_EPS) * jax.nn.silu(g[:, lo:])


def gla_chunkwise(q, k, v, log_f, chunk=HGRN_CHUNK):
    nz, bsz, n_tok, nh, dk = q.shape
    dv = v.shape[-1]
    n_chunk = n_tok // chunk

    def blocks(t):
        return jnp.moveaxis(t.reshape(nz, bsz, n_chunk, chunk, nh, t.shape[-1]), 2, 0)
    causal = jnp.tril(jnp.ones((chunk, chunk), dtype=bool))

    def step(S, inp):
        qc, kc, vc, lfc = inp
        b = jnp.cumsum(lfc, axis=2)
        rel = b[:, :, :, None] - b[:, :, None, :]
        dec = jnp.where(causal[:, :, None, None], jnp.exp(jnp.minimum(rel, 0.0)), 0.0).astype(qc.dtype)
        A = jnp.einsum('zbthc,zbtshc,zbshc->zbhts', qc, dec, kc)
        o = (jnp.einsum('zbhts,zbshe->zbthe', A, vc)
             + jnp.einsum('zbthc,zbhce->zbthe', qc * jnp.exp(b).astype(qc.dtype), S))
        b_last = b[:, :, -1:]
        S = (S * jnp.exp(b_last[:, :, 0])[..., None].astype(S.dtype)
             + jnp.einsum('zbshc,zbshe->zbhce', kc * jnp.exp(b_last - b).astype(kc.dtype), vc)).astype(S.dtype)
        return S, o
    S0 = jnp.zeros((nz, bsz, nh, dk, dv), v.dtype)
    _, o = lax.scan(step, S0, (blocks(q), blocks(k), blocks(v), blocks(log_f)))
    return jnp.moveaxis(o, 0, 2).reshape(nz, bsz, n_tok, nh, dv)


def hgrn2_mixer(z, n_ctx, lo, lower, norm_g):
    q, f, i, g = split_cols(z, HGRN_COLS)
    bsz, n_tok, _ = z.shape
    f = jnp.moveaxis(f.reshape(bsz, n_tok, 2, MIX_W), 2, 0).astype(jnp.float32)
    lb = lower[:, None, None, :].astype(jnp.float32)
    log_lb = jnp.log(jnp.maximum(lb, HGRN_LB_FLOOR))
    log_f = jnp.logaddexp(jax.nn.log_sigmoid(f), log_lb + jax.nn.log_sigmoid(-f))
    k = ((1.0 - lb) * jax.nn.sigmoid(-f)).astype(z.dtype)
    y = gla_chunkwise(orient(both_dirs(heads(jax.nn.silu(q))), n_ctx), orient(heads(k), n_ctx),
                      orient(both_dirs(heads(i)), n_ctx), orient(heads(log_f), n_ctx))
    y = deorient_sum(y, n_ctx)[:, lo:]
    return merge_heads(rms_norm(y, heads(norm_g))) * jax.nn.silu(g[:, lo:])


def gqa_mixer(z, n_ctx, need_ctx, cos, sin, q_g, k_g):
    q, k, v = split_cols(z, ATTN_COLS)
    q = rope_latent(rms_norm(heads(q), q_g), n_ctx, cos, sin) * HEAD_DIM ** -0.5
    k = rope_latent(rms_norm(heads(k), k_g), n_ctx, cos, sin)
    v = heads(v)
    bsz, n_tok = z.shape[0], z.shape[1]
    n_lat = n_tok - n_ctx
    group = MIX_HEADS // ATTN_KV_HEADS
    q = q.reshape(bsz, n_tok, ATTN_KV_HEADS, group, HEAD_DIM)

    def attend(qb, kb, vb):
        s = jnp.einsum('bqhgd,bkhd->bhgqk', qb, kb).astype(jnp.float32)
        p = jax.nn.softmax(s, axis=-1).astype(vb.dtype)
        return jnp.einsum('bhgqk,bkhd->bqhgd', p, vb)
    q_blocks = jnp.moveaxis(q[:, n_ctx:].reshape(bsz, n_lat // ATTN_BLOCK, ATTN_BLOCK, ATTN_KV_HEADS, group, HEAD_DIM), 1, 0)
    o_lat = lax.map(lambda qb: attend(qb, k, v), q_blocks)
    o_lat = jnp.moveaxis(o_lat, 0, 1).reshape(bsz, n_lat, MIX_W)
    if not need_ctx:
        return o_lat
    o_ctx = attend(q[:, :n_ctx], k[:, :n_ctx], v[:, :n_ctx]).reshape(bsz, n_ctx, MIX_W)
    return jnp.concatenate([o_ctx, o_lat], axis=1)


def expert_choice_ffn(u, w_router, w_e1, w_e3, w_e2):
    bsz, n_tok, _ = u.shape
    cap = EC_CAPACITY * n_tok // N_EXPERTS
    aff = jax.nn.softmax((u @ w_router).astype(jnp.float32), axis=-1)
    gate, idx = lax.top_k(jnp.swapaxes(aff, 1, 2), cap)
    bidx = jnp.arange(bsz)[:, None, None]
    xs = u[bidx, idx]
    h = jax.nn.silu(jnp.einsum('becd,edf->becf', xs, w_e1)) * jnp.einsum('becd,edf->becf', xs, w_e3)
    y = jnp.einsum('becf,efd->becd', h, w_e2) * gate[..., None].astype(u.dtype)
    return jnp.zeros_like(u).at[bidx, idx].add(y)


def trunk_layer(x_ctx, x_lat, c, c_ctx, cos, sin, hgrn_lower, need_ctx, p):
    n_ctx = x_ctx.shape[1]
    lo = 0 if need_ctx else n_ctx
    mod_lat = jax.nn.silu(c) @ p['w_mod'] + p['b_mod']
    mod_ctx = jax.nn.silu(c_ctx) @ p['w_mod'] + p['b_mod']
    sh1, sc1, g1, sh2, sc2, g2 = jnp.split(mod_lat[:, None, :], 6, axis=-1)
    sh1c, sc1c, g1c, sh2c, sc2c, g2c = jnp.split(mod_ctx, 6, axis=-1)
    u = jnp.concatenate([x_ctx * (1 + sc1c) + sh1c, x_lat * (1 + sc1) + sh1], axis=1)
    z = u @ p['w_in']
    z_a, z_b, z_c, z_d = split_cols(z, GROUP_COLS)
    branches = (
        rwkv7_mixer(z_a, n_ctx, lo, p['rwkv_mu'], p['rwkv_w0'], p['rwkv_w2'], p['rwkv_a0'], p['rwkv_a2'],
                    p['rwkv_g2'], p['rwkv_kk'], p['rwkv_ka'], p['rwkv_rk'], p['rwkv_ln_g'], p['rwkv_ln_b']),
        retention_mixer(z_b, n_ctx, lo, cos, sin, p['ret_decay'], p['ret_norm_g'], p['ret_norm_b']),
        hgrn2_mixer(z_c, n_ctx, lo, hgrn_lower, p['hgrn_norm_g']),
        gqa_mixer(z_d, n_ctx, need_ctx, cos, sin, p['attn_q_g'], p['attn_k_g']),
    )
    u_rows = u[:, lo:]
    merged = None
    for i in range(N_BRANCH):
        term = jax.nn.sigmoid(u_rows @ p['w_gate'][i]) * (branches[i] @ p['w_branch'][i])
        merged = term if merged is None else merged + term
    mix = merged @ p['w_out']
    n0 = n_ctx - lo
    x_lat = layer_norm(DEEPNORM_ALPHA * x_lat + g1 * mix[:, n0:], p['ln1_g'], p['ln1_b'])
    ffn_lat = expert_choice_ffn(x_lat * (1 + sc2) + sh2, p['w_router'], p['w_e1'], p['w_e3'], p['w_e2'])
    x_lat = layer_norm(DEEPNORM_ALPHA * x_lat + g2 * ffn_lat, p['ln2_g'], p['ln2_b'])
    if need_ctx:
        x_ctx = layer_norm(DEEPNORM_ALPHA * x_ctx + g1c * mix[:, :n_ctx], p['ln1_g'], p['ln1_b'])
        ffn_ctx = expert_choice_ffn(x_ctx * (1 + sc2c) + sh2c, p['w_router'], p['w_e1'], p['w_e3'], p['w_e2'])
        x_ctx = layer_norm(DEEPNORM_ALPHA * x_ctx + g2c * ffn_ctx, p['ln2_g'], p['ln2_b'])
    return x_ctx, x_lat


def setup_inputs(seed: int = 0) -> dict:
    key = jax.random.key(seed)
    ks = iter(jax.random.split(key, 40))

    def nrm(shape, scale):
        return scale * jax.random.normal(next(ks), shape, jnp.float32)

    def unif(shape, lo, hi):
        return jax.random.uniform(next(ks), shape, jnp.float32, lo, hi)
    L, D = DEPTH, D_MODEL
    ret_base = jnp.log(2.0 ** (5.0 + jnp.arange(MIX_HEADS, dtype=jnp.float32)) - 1.0)
    return {
        'x': nrm((BATCH, SEQ, D), 1.0),
        'c': nrm((BATCH, D), 1.0),
        'ctx': nrm((BATCH, CTX_LEN, D), 1.0),
        'c_ctx': nrm((D,), 1.0),
        'w_mod': nrm((L, D, 6 * D), 0.5 * D ** -0.5),
        'b_mod': nrm((L, 6 * D), 0.02),
        'w_in': nrm((L, D, D_IN), D ** -0.5),
        'rwkv_mu': unif((L, GROUP_COLS[0]), 0.0, 1.0),
        'rwkv_w0': unif((L, 2, MIX_W), -5.0, 1.0),
        'rwkv_w2': nrm((L, 2, RWKV_LORA_W, MIX_W), 0.1 * RWKV_LORA_W ** -0.5),
        'rwkv_a0': nrm((L, 2, MIX_W), 0.5),
        'rwkv_a2': nrm((L, 2, RWKV_LORA_A, MIX_W), 0.5 * RWKV_LORA_A ** -0.5),
        'rwkv_g2': nrm((L, RWKV_LORA_G, MIX_W), RWKV_LORA_G ** -0.5),
        'rwkv_kk': 0.85 + nrm((L, MIX_W), 0.05),
        'rwkv_ka': 1.0 + nrm((L, MIX_W), 0.05),
        'rwkv_rk': nrm((L, MIX_W), 0.1),
        'rwkv_ln_g': 1.0 + nrm((L, MIX_W), 0.05),
        'rwkv_ln_b': nrm((L, MIX_W), 0.02),
        'ret_decay': ret_base + nrm((L, 2, MIX_HEADS), 0.1),
        'ret_norm_g': 1.0 + nrm((L, MIX_W), 0.05),
        'ret_norm_b': nrm((L, MIX_W), 0.02),
        'hgrn_lb': 1.0 + nrm((2, L, MIX_W), 0.1),
        'hgrn_norm_g': 1.0 + nrm((L, MIX_W), 0.05),
        'attn_q_g': 1.0 + nrm((L, HEAD_DIM), 0.05),
        'attn_k_g': 1.0 + nrm((L, HEAD_DIM), 0.05),
        'w_gate': nrm((L, N_BRANCH, D, D), D ** -0.5),
        'w_branch': nrm((L, N_BRANCH, MIX_W, D), MIX_W ** -0.5),
        'w_out': nrm((L, D, D), DEEPNORM_BETA * D ** -0.5),
        'ln1_g': 1.0 + nrm((L, D), 0.05),
        'ln1_b': nrm((L, D), 0.02),
        'w_router': nrm((L, D, N_EXPERTS), D ** -0.5),
        'w_e1': nrm((L, N_EXPERTS, D, D_EXPERT), D ** -0.5),
        'w_e3': nrm((L, N_EXPERTS, D, D_EXPERT), D ** -0.5),
        'w_e2': nrm((L, N_EXPERTS, D_EXPERT, D), DEEPNORM_BETA * D_EXPERT ** -0.5),
        'ln2_g': 1.0 + nrm((L, D), 0.05),
        'ln2_b': nrm((L, D), 0.02),
    }


def reference(x, c, ctx, c_ctx, w_mod, b_mod, w_in, rwkv_mu, rwkv_w0, rwkv_w2, rwkv_a0, rwkv_a2, rwkv_g2,
              rwkv_kk, rwkv_ka, rwkv_rk, rwkv_ln_g, rwkv_ln_b, ret_decay, ret_norm_g, ret_norm_b, hgrn_lb,
              hgrn_norm_g, attn_q_g, attn_k_g, w_gate, w_branch, w_out, ln1_g, ln1_b, w_router, w_e1, w_e3,
              w_e2, ln2_g, ln2_b):
    cos, sin = axial_rope_tables(x.shape[1], x.dtype)
    lb_w = jax.nn.softmax(hgrn_lb.astype(jnp.float32), axis=1)
    lower = jnp.cumsum(lb_w, axis=1) - lb_w[:, :1]
    x_ctx, x_lat = ctx, x
    for l in range(DEPTH):
        p = {
            'w_mod': w_mod[l], 'b_mod': b_mod[l], 'w_in': w_in[l],
            'rwkv_mu': rwkv_mu[l], 'rwkv_w0': rwkv_w0[l], 'rwkv_w2': rwkv_w2[l], 'rwkv_a0': rwkv_a0[l],
            'rwkv_a2': rwkv_a2[l], 'rwkv_g2': rwkv_g2[l], 'rwkv_kk': rwkv_kk[l], 'rwkv_ka': rwkv_ka[l],
            'rwkv_rk': rwkv_rk[l], 'rwkv_ln_g': rwkv_ln_g[l], 'rwkv_ln_b': rwkv_ln_b[l],
            'ret_decay': ret_decay[l], 'ret_norm_g': ret_norm_g[l], 'ret_norm_b': ret_norm_b[l],
            'hgrn_norm_g': hgrn_norm_g[l], 'attn_q_g': attn_q_g[l], 'attn_k_g': attn_k_g[l],
            'w_gate': w_gate[l], 'w_branch': w_branch[l], 'w_out': w_out[l], 'ln1_g': ln1_g[l], 'ln1_b': ln1_b[l],
            'w_router': w_router[l], 'w_e1': w_e1[l], 'w_e3': w_e3[l], 'w_e2': w_e2[l],
            'ln2_g': ln2_g[l], 'ln2_b': ln2_b[l],
        }
        x_ctx, x_lat = trunk_layer(x_ctx, x_lat, c, c_ctx, cos, sin, lower[:, l], l < DEPTH - 1, p)
    return x_lat
```

```cpp
#include <hip/hip_runtime.h>
#include <hip/hip_cooperative_groups.h>
#include <stdint.h>
#include <stdio.h>
namespace cg = cooperative_groups;

typedef unsigned short bf16_t;
using bf16x8 = __attribute__((ext_vector_type(8))) short;
using f32x16 = __attribute__((ext_vector_type(16))) float;
typedef unsigned long long u64;
#define DEV __device__ __forceinline__

constexpr int NB_ = 16, T_ = 2304, NC_ = 256, NL_ = 2048, D_ = 1024, ROWS_ = NB_ * T_;
constexpr float ALPHA = 1.41421356237309515f;
constexpr size_t MiB = 1ull << 20;
constexpr size_t OFF_MOD = 0, OFF_COS = 1 * MiB, OFF_SIN = 1 * MiB + 262144, OFF_AFF = 2 * MiB,
                 OFF_IDX = 5 * MiB, OFF_GATE = 5 * MiB + 512 * 1024;
constexpr size_t OFF_XA = 6 * MiB, OFF_ZA = 150 * MiB, OFF_ZB = 231 * MiB, OFF_ZC = 303 * MiB, OFF_ZD = 393 * MiB,
                 OFF_RWW = 429 * MiB, OFF_RWA = 501 * MiB, OFF_RWR = 537 * MiB, OFF_RWG = 609 * MiB;
constexpr size_t WS_NEED = 645 * MiB;
constexpr size_t OFF_Y0 = OFF_ZA, OFF_H = OFF_ZA, OFF_BR = OFF_RWW, OFF_MRG = OFF_RWR, OFF_FCTX = OFF_RWG;
constexpr size_t OUT_Y1 = 0, OUT_Y2 = 36 * MiB, OUT_ATQ = 72 * MiB, OUT_ATK = 90 * MiB, OUT_ATO = 99 * MiB;
constexpr size_t RWSZ = (size_t)ROWS_ * 256;

struct P {
  const float* in[36];
  float* out;
  char* ws;
};

DEV float bf2f(bf16_t v) { return __uint_as_float(((unsigned)v) << 16); }
DEV bf16_t f2bf(float f) {
  unsigned u = __float_as_uint(f);
  u += 0x7FFFu + ((u >> 16) & 1u);
  return (bf16_t)(u >> 16);
}
DEV unsigned pack2(float a, float b) { return (unsigned)f2bf(a) | ((unsigned)f2bf(b) << 16); }
DEV float sigmoidf_(float x) { return 1.f / (1.f + __expf(-x)); }
DEV float siluf_(float x) { return x / (1.f + __expf(-x)); }
DEV float wave_sum(float v) {
#pragma unroll
  for (int o = 32; o > 0; o >>= 1) v += __shfl_xor(v, o, 64);
  return v;
}
DEV float f4c(const float4& v, int c) { return c == 0 ? v.x : (c == 1 ? v.y : (c == 2 ? v.z : v.w)); }

DEV const float* xin_row(const P& p, int l, int row) {
  if (l == 0) {
    int b = row / T_, t = row - b * T_;
    return t < NC_ ? p.in[2] + ((size_t)(b * NC_ + t)) * D_ : p.in[0] + ((size_t)(b * NL_ + t - NC_)) * D_;
  }
  return (const float*)(p.ws + OFF_XA) + (size_t)row * D_;
}
DEV const float* mod_row(const P& p, int l, int row) {
  int b = row / T_, t = row - b * T_;
  return (const float*)(p.ws + OFF_MOD) + (size_t)(l * 17 + (t < NC_ ? 16 : b)) * 6144;
}
DEV int map_row(int l, int mrow) { return l == 0 ? mrow : (mrow >> 11) * T_ + NC_ + (mrow & 2047); }
DEV int n_mrows(int l) { return l == 0 ? ROWS_ : NB_ * NL_; }

struct GemmSmem {
  bf16_t a[128 * 40];
  bf16_t b[2][128 * 40];
};

struct ALModX {
  const float* xp[2];
  const float* mp[2];
  DEV uint4 load(int i, int k) const {
    float4 x0 = *(const float4*)(xp[i] + k), x1 = *(const float4*)(xp[i] + k + 4);
    float4 h0 = *(const float4*)(mp[i] + k), h1 = *(const float4*)(mp[i] + k + 4);
    float4 s0 = *(const float4*)(mp[i] + 1024 + k), s1 = *(const float4*)(mp[i] + 1024 + k + 4);
    uint4 o;
    o.x = pack2(x0.x * (1.f + s0.x) + h0.x, x0.y * (1.f + s0.y) + h0.y);
    o.y = pack2(x0.z * (1.f + s0.z) + h0.z, x0.w * (1.f + s0.w) + h0.w);
    o.z = pack2(x1.x * (1.f + s1.x) + h1.x, x1.y * (1.f + s1.y) + h1.y);
    o.w = pack2(x1.z * (1.f + s1.z) + h1.z, x1.w * (1.f + s1.w) + h1.w);
    return o;
  }
};
struct ALBf {
  const bf16_t* ap[2];
  DEV uint4 load(int i, int k) const { return *(const uint4*)(ap[i] + k); }
};

template <int NBM, class AL>
DEV void gemm_core(const AL& al, const float* B0, const float* B1, int ldb, int K, GemmSmem* sm,
                   f32x16 (&acc)[NBM][2][2]) {
  const int tid = threadIdx.x, lane = tid & 63, w = tid >> 6, wm = w >> 1, wn = w & 1, r = lane & 31, h = lane >> 5;
  const int nq = tid & 31, kq = tid >> 5;
  uint4 ra[2];
  float4 rb[NBM][4];
  auto gload = [&](int k0) {
#pragma unroll
    for (int i = 0; i < 2; ++i) ra[i] = al.load(i, k0 + 8 * (tid & 3));
#pragma unroll
    for (int nb = 0; nb < NBM; ++nb) {
      const float* Bp = (nb == 0 ? B0 : B1) + (size_t)(k0 + 4 * kq) * ldb + 4 * nq;
#pragma unroll
      for (int j = 0; j < 4; ++j) rb[nb][j] = *(const float4*)(Bp + (size_t)j * ldb);
    }
  };
  gload(0);
  const int KT = K >> 5;
  for (int kt = 0; kt < KT; ++kt) {
    __syncthreads();
#pragma unroll
    for (int i = 0; i < 2; ++i) *(uint4*)&sm->a[((tid >> 2) + 64 * i) * 40 + 8 * (tid & 3)] = ra[i];
#pragma unroll
    for (int nb = 0; nb < NBM; ++nb) {
#pragma unroll
      for (int c = 0; c < 4; ++c) {
        uint2 v;
        v.x = pack2(f4c(rb[nb][0], c), f4c(rb[nb][1], c));
        v.y = pack2(f4c(rb[nb][2], c), f4c(rb[nb][3], c));
        *(uint2*)&sm->b[nb][(4 * nq + c) * 40 + 4 * kq] = v;
      }
    }
    __syncthreads();
    if (kt + 1 < KT) gload((kt + 1) << 5);
#pragma unroll
    for (int ks = 0; ks < 2; ++ks) {
      bf16x8 af[2], bfr[NBM][2];
#pragma unroll
      for (int mi = 0; mi < 2; ++mi) af[mi] = *(const bf16x8*)&sm->a[(64 * wm + 32 * mi + r) * 40 + ks * 16 + 8 * h];
#pragma unroll
      for (int nb = 0; nb < NBM; ++nb)
#pragma unroll
        for (int ni = 0; ni < 2; ++ni)
          bfr[nb][ni] = *(const bf16x8*)&sm->b[nb][(64 * wn + 32 * ni + r) * 40 + ks * 16 + 8 * h];
#pragma unroll
      for (int nb = 0; nb < NBM; ++nb)
#pragma unroll
        for (int mi = 0; mi < 2; ++mi)
#pragma unroll
          for (int ni = 0; ni < 2; ++ni)
            acc[nb][mi][ni] = __builtin_amdgcn_mfma_f32_32x32x16_bf16(af[mi], bfr[nb][ni], acc[nb][mi][ni], 0, 0, 0);
    }
  }
}

template <int NBM>
DEV void acc_zero(f32x16 (&acc)[NBM][2][2]) {
#pragma unroll
  for (int nb = 0; nb < NBM; ++nb)
#pragma unroll
    for (int mi = 0; mi < 2; ++mi)
#pragma unroll
      for (int ni = 0; ni < 2; ++ni)
#pragma unroll
        for (int e = 0; e < 16; ++e) acc[nb][mi][ni][e] = 0.f;
}
#define ACC_ROW(mi, reg) (64 * wm + 32 * (mi) + ((reg) & 3) + 8 * ((reg) >> 2) + 4 * h)
#define ACC_COL(ni) (64 * wn + 32 * (ni) + r)
#define ACC_IDS                                                                                     \
  const int tid = threadIdx.x, lane = tid & 63, w = tid >> 6, wm = w >> 1, wn = w & 1, r = lane & 31, \
            h = lane >> 5;                                                                          \
  (void)tid; (void)lane; (void)w; (void)wm; (void)wn; (void)r; (void)h;

DEV void phase_mod(const P& p, char* smem) {
  float* sc = (float*)smem;
  float* red = sc + 17 * 256;
  const int tid = threadIdx.x, kg = tid >> 6, cn = tid & 63;
  float* MOD = (float*)(p.ws + OFF_MOD);
  for (int task = blockIdx.x; task < 192; task += gridDim.x) {
    const int l = task / 96, n0 = (task % 96) * 64;
    const float* W = p.in[4] + (size_t)l * 1024 * 6144;
    float acc[17];
#pragma unroll
    for (int i = 0; i < 17; ++i) acc[i] = 0.f;
    for (int s = 0; s < 4; ++s) {
      __syncthreads();
      for (int i = tid; i < 17 * 256; i += 256) {
        int rr = i >> 8, k = i & 255;
        float c = (rr < 16) ? p.in[1][rr * 1024 + s * 256 + k] : p.in[3][s * 256 + k];
        sc[i] = siluf_(c);
      }
      __syncthreads();
      for (int kk = 0; kk < 64; ++kk) {
        int k = kg * 64 + kk;
        float wv = W[(size_t)(s * 256 + k) * 6144 + n0 + cn];
#pragma unroll
        for (int rr = 0; rr < 17; ++rr) acc[rr] += sc[rr * 256 + k] * wv;
      }
    }
#pragma unroll
    for (int rr = 0; rr < 17; ++rr) red[(kg * 17 + rr) * 64 + cn] = acc[rr];
    __syncthreads();
    for (int i = tid; i < 17 * 64; i += 256) {
      int rr = i >> 6, c = i & 63;
      float v = red[(0 * 17 + rr) * 64 + c] + red[(1 * 17 + rr) * 64 + c] + red[(2 * 17 + rr) * 64 + c] +
                red[(3 * 17 + rr) * 64 + c];
      MOD[(size_t)(l * 17 + rr) * 6144 + n0 + c] = v + p.in[5][l * 6144 + n0 + c];
    }
    __syncthreads();
  }
  float* COS = (float*)(p.ws + OFF_COS);
  float* SIN = (float*)(p.ws + OFF_SIN);
  for (int i = blockIdx.x * 256 + tid; i < 2048 * 32; i += gridDim.x * 256) {
    int n = i >> 5, j = i & 31;
    int rowi = n >> 6, coli = n & 63;
    float inv = powf(10000.f, -(float)(j & 15) / 16.f);
    float ang = (float)(j < 16 ? rowi : coli) * inv;
    COS[i] = cosf(ang);
    SIN[i] = sinf(ang);
  }
}

DEV void phase_in(const P& p, int l, char* smem) {
  GemmSmem* sm = (GemmSmem*)smem;
  ACC_IDS
  const float* Win = p.in[6] + (size_t)l * 1024 * 3968;
  for (int tile = blockIdx.x; tile < 288 * 31; tile += gridDim.x) {
    const int mt = tile / 31, nt = tile % 31;
    ALModX al;
#pragma unroll
    for (int i = 0; i < 2; ++i) {
      int row = mt * 128 + (tid >> 2) + 64 * i;
      al.xp[i] = xin_row(p, l, row);
      al.mp[i] = mod_row(p, l, row);
    }
    f32x16 acc[1][2][2];
    acc_zero<1>(acc);
    gemm_core<1>(al, Win + nt * 128, nullptr, 3968, 1024, sm, acc);
    bf16_t* Z;
    int ld, c0;
    if (nt < 9) { Z = (bf16_t*)(p.ws + OFF_ZA); ld = 1152; c0 = nt * 128; }
    else if (nt < 17) { Z = (bf16_t*)(p.ws + OFF_ZB); ld = 1024; c0 = (nt - 9) * 128; }
    else if (nt < 27) { Z = (bf16_t*)(p.ws + OFF_ZC); ld = 1280; c0 = (nt - 17) * 128; }
    else { Z = (bf16_t*)(p.ws + OFF_ZD); ld = 512; c0 = (nt - 27) * 128; }
#pragma unroll
    for (int mi = 0; mi < 2; ++mi)
#pragma unroll
      for (int ni = 0; ni < 2; ++ni)
#pragma unroll
        for (int e = 0; e < 16; ++e) {
          int row = mt * 128 + ACC_ROW(mi, e), col = c0 + ACC_COL(ni);
          Z[(size_t)row * ld + col] = f2bf(acc[0][mi][ni][e]);
        }
  }
}

DEV float za_mix(const bf16_t* ZA, const float* mu, int b, int t, int col) {
  const bf16_t* z = ZA + ((size_t)b * T_ + t) * 1152 + col;
  float zc = bf2f(z[0]);
  bool hasl = (t != 0 && t != NC_), hasr = (t != NC_ - 1 && t != T_ - 1);
  float zl = hasl ? bf2f(z[-1152]) : 0.f;
  float zr = hasr ? bf2f(z[1152]) : 0.f;
  return zc + mu[col] * (0.5f * (zl + zr) - zc);
}

DEV void phase_prep(const P& p, int l, char* smem) {
  float* lz = (float*)smem;
  const int tid = threadIdx.x, lane = tid & 63, wv = tid >> 6;
  const bf16_t* ZA = (const bf16_t*)(p.ws + OFF_ZA);
  const bf16_t* ZD = (const bf16_t*)(p.ws + OFF_ZD);
  const float* mu = p.in[7] + l * 1152;
  float* RWW = (float*)(p.ws + OFF_RWW);
  bf16_t* RWA = (bf16_t*)(p.ws + OFF_RWA);
  bf16_t* RWR = (bf16_t*)(p.ws + OFF_RWR);
  bf16_t* RWK = RWR + RWSZ;
  bf16_t* RWV = RWK + RWSZ;
  bf16_t* RWKK = RWV + RWSZ;
  bf16_t* RWG = (bf16_t*)(p.ws + OFF_RWG);
  bf16_t* RWBG = RWG + RWSZ;
  bf16_t* ATQ = (bf16_t*)((char*)p.out + OUT_ATQ);
  bf16_t* ATK = (bf16_t*)((char*)p.out + OUT_ATK);
  const float* COS = (const float*)(p.ws + OFF_COS);
  const float* SIN = (const float*)(p.ws + OFF_SIN);
  const int NT1 = 16 * 288, NT2 = ROWS_ / 4;
  for (int task = blockIdx.x; task < NT1 + NT2; task += gridDim.x) {
    if (task < NT1) {
      const int b = task / 288, t0 = (task % 288) * 8;
      __syncthreads();
      for (int i = tid; i < 3072; i += 256) {
        int tk = i / 384, col = i - tk * 384;
        float v = za_mix(ZA, mu, b, t0 + tk, 768 + col);
        if (col < 128) v = tanhf(v);
        else if (col >= 256) v = sigmoidf_(v);
        lz[i] = v;
      }
      __syncthreads();
      const int c = tid;
      float aw0[8], aw1[8], aa0[8], aa1[8], ag[8];
#pragma unroll
      for (int i = 0; i < 8; ++i) aw0[i] = aw1[i] = aa0[i] = aa1[i] = ag[i] = 0.f;
      const float* W2 = p.in[9] + (size_t)l * 2 * 64 * 256;
      const float* A2 = p.in[11] + (size_t)l * 2 * 64 * 256;
      const float* G2 = p.in[12] + (size_t)l * 128 * 256;
      for (int rr = 0; rr < 64; ++rr) {
        float w0v = W2[rr * 256 + c], w1v = W2[(64 + rr) * 256 + c];
        float a0v = A2[rr * 256 + c], a1v = A2[(64 + rr) * 256 + c];
#pragma unroll
        for (int tk = 0; tk < 8; ++tk) {
          aw0[tk] += lz[tk * 384 + rr] * w0v;
          aw1[tk] += lz[tk * 384 + 64 + rr] * w1v;
          aa0[tk] += lz[tk * 384 + 128 + rr] * a0v;
          aa1[tk] += lz[tk * 384 + 192 + rr] * a1v;
        }
      }
      for (int rr = 0; rr < 128; ++rr) {
        float gv = G2[rr * 256 + c];
#pragma unroll
        for (int tk = 0; tk < 8; ++tk) ag[tk] += lz[tk * 384 + 256 + rr] * gv;
      }
      const float w00 = p.in[8][(l * 2 + 0) * 256 + c], w01 = p.in[8][(l * 2 + 1) * 256 + c];
      const float a00 = p.in[10][(l * 2 + 0) * 256 + c], a01 = p.in[10][(l * 2 + 1) * 256 + c];
      const float k_k = p.in[13][l * 256 + c], r_k = p.in[15][l * 256 + c];
#pragma unroll
      for (int tk = 0; tk < 8; ++tk) {
        const int t = t0 + tk;
        const size_t row = (size_t)b * T_ + t;
        float rv = za_mix(ZA, mu, b, t, c);
        float kv = za_mix(ZA, mu, b, t, 256 + c);
        float vv = za_mix(ZA, mu, b, t, 512 + c);
        float kkf = kv * k_k;
        float ss = wave_sum(kkf * kkf);
        float kk = kkf * rsqrtf(ss + 1e-12f);
        float rk = wave_sum(rv * kv * r_k);
        float g = ag[tk];
#pragma unroll
        for (int d = 0; d < 2; ++d) {
          float wr = (d == 0 ? w00 + aw0[tk] : w01 + aw1[tk]);
          float x = -wr;
          float sp = fmaxf(x, 0.f) + log1pf(__expf(-fabsf(x)));
          float decay = __expf(-__expf(-sp - 0.5f));
          float a = sigmoidf_(d == 0 ? a00 + aa0[tk] : a01 + aa1[tk]);
          RWW[(size_t)d * RWSZ + row * 256 + c] = decay;
          RWA[(size_t)d * RWSZ + row * 256 + c] = f2bf(a);
        }
        RWR[row * 256 + c] = f2bf(rv);
        RWK[row * 256 + c] = f2bf(kv);
        RWV[row * 256 + c] = f2bf(vv);
        RWKK[row * 256 + c] = f2bf(kk);
        RWG[row * 256 + c] = f2bf(g);
        RWBG[row * 256 + c] = f2bf(rk * vv * g);
      }
    } else {
      const int row = (task - NT1) * 4 + wv;
      const int t = row % T_;
      const bf16_t* z = ZD + (size_t)row * 512;
      const int pidx = lane & 31;
      float cs = 1.f, sn = 0.f;
      if (t >= NC_) { cs = COS[(t - NC_) * 32 + pidx]; sn = SIN[(t - NC_) * 32 + pidx]; }
#pragma unroll
      for (int hd = 0; hd < 6; ++hd) {
        float x = bf2f(z[hd * 64 + lane]);
        float ms = wave_sum(x * x) * (1.f / 64.f);
        float g = (hd < 4) ? p.in[23][l * 64 + lane] : p.in[24][l * 64 + lane];
        float xn = x * rsqrtf(ms + 1e-6f) * g;
        float pr = __shfl_xor(xn, 32, 64);
        float o = (lane < 32) ? (xn * cs - pr * sn) : (pr * sn + xn * cs);
        if (hd < 4) ATQ[(size_t)row * 256 + hd * 64 + lane] = f2bf(o * 0.125f);
        else ATK[(size_t)row * 128 + (hd - 4) * 64 + lane] = f2bf(o);
      }
    }
  }
}

DEV int scan_tok(int d, int j) { return d == 0 ? j : (j < NC_ ? NC_ - 1 - j : (T_ + NC_ - 1) - j); }

DEV void wave_lds_sync() {
  __builtin_amdgcn_fence(__ATOMIC_RELEASE, "wavefront");
  __builtin_amdgcn_wave_barrier();
  __builtin_amdgcn_fence(__ATOMIC_ACQUIRE, "wavefront");
}

template <int MIX>
DEV void scan_task(const P& p, int l, int task, float* L) {
  const int lane = threadIdx.x & 63;
  const int d = task & 1, hh = (task >> 1) & 3, b = task >> 3;
  const int c = hh * 64 + lane;
  float S[64];
#pragma unroll
  for (int i = 0; i < 64; ++i) S[i] = 0.f;
  const float* RWW = (const float*)(p.ws + OFF_RWW) + (size_t)d * RWSZ;
  const bf16_t* RWA = (const bf16_t*)(p.ws + OFF_RWA) + (size_t)d * RWSZ;
  const bf16_t* RWR = (const bf16_t*)(p.ws + OFF_RWR);
  const bf16_t* RWK = RWR + RWSZ;
  const bf16_t* RWV = RWK + RWSZ;
  const bf16_t* RWKK = RWV + RWSZ;
  const bf16_t* ZB = (const bf16_t*)(p.ws + OFF_ZB);
  const bf16_t* ZC = (const bf16_t*)(p.ws + OFF_ZC);
  const float* COS = (const float*)(p.ws + OFF_COS);
  const float* SIN = (const float*)(p.ws + OFF_SIN);
  bf16_t* Y = (MIX == 0) ? (bf16_t*)(p.ws + OFF_Y0)
                         : (MIX == 1 ? (bf16_t*)((char*)p.out + OUT_Y1) : (bf16_t*)((char*)p.out + OUT_Y2));
  Y += (size_t)d * RWSZ;
  float cst0 = 0.f, cst1 = 0.f;
  if (MIX == 0) cst0 = p.in[14][l * 256 + c];
  if (MIX == 1) cst0 = sigmoidf_(p.in[18][(l * 2 + d) * 4 + hh]);
  if (MIX == 2) {
    float h0 = p.in[21][(d * 2 + 0) * 256 + c], h1 = p.in[21][(d * 2 + 1) * 256 + c];
    cst0 = (l == 0) ? 0.f : sigmoidf_(h1 - h0);
    cst1 = 1.f - cst0;
  }
  constexpr int NV = (MIX == 0) ? 6 : (MIX == 1 ? 7 : 3);
  float pf[8][NV];
  auto issue = [&](int j0) {
#pragma unroll
    for (int s = 0; s < 8; ++s) {
      const int t = scan_tok(d, j0 + s);
      const size_t row = (size_t)b * T_ + t;
      if (MIX == 0) {
        pf[s][0] = RWW[row * 256 + c];
        pf[s][1] = bf2f(RWA[row * 256 + c]);
        pf[s][2] = bf2f(RWR[row * 256 + c]);
        pf[s][3] = bf2f(RWK[row * 256 + c]);
        pf[s][4] = bf2f(RWKK[row * 256 + c]);
        pf[s][5] = bf2f(RWV[row * 256 + c]);
      } else if (MIX == 1) {
        const bf16_t* z = ZB + row * 1024;
        pf[s][0] = bf2f(z[c]);
        pf[s][1] = bf2f(z[c ^ 32]);
        pf[s][2] = bf2f(z[256 + c]);
        pf[s][3] = bf2f(z[256 + (c ^ 32)]);
        pf[s][4] = bf2f(z[512 + c]);
        if (t >= NC_) {
          pf[s][5] = COS[(t - NC_) * 32 + (lane & 31)];
          pf[s][6] = SIN[(t - NC_) * 32 + (lane & 31)];
        } else {
          pf[s][5] = 1.f;
          pf[s][6] = 0.f;
        }
      } else {
        const bf16_t* z = ZC + row * 1280;
        pf[s][0] = bf2f(z[c]);
        pf[s][1] = bf2f(z[256 + d * 256 + c]);
        pf[s][2] = bf2f(z[768 + c]);
      }
    }
  };
  auto commit = [&]() {
#pragma unroll
    for (int s = 0; s < 8; ++s) {
      float* Ls = L + s * 384;
      if (MIX == 0) {
        float wd = pf[s][0], a = pf[s][1], rv = pf[s][2], kv = pf[s][3], kk = pf[s][4], vv = pf[s][5];
        Ls[lane] = wd;
        Ls[64 + lane] = kk;
        Ls[128 + lane] = kk * a;
        Ls[192 + lane] = kv * (1.f + (a - 1.f) * cst0);
        Ls[256 + lane] = rv;
        Ls[320 + lane] = vv;
      } else if (MIX == 1) {
        float cs = pf[s][5], sn = pf[s][6];
        float q = (lane < 32) ? (pf[s][0] * cs - pf[s][1] * sn) : (pf[s][1] * sn + pf[s][0] * cs);
        float k = (lane < 32) ? (pf[s][2] * cs - pf[s][3] * sn) : (pf[s][3] * sn + pf[s][2] * cs);
        Ls[lane] = q;
        Ls[64 + lane] = k * 0.125f;
        Ls[128 + lane] = pf[s][4];
      } else {
        float x = pf[s][1];
        float sg = 1.f / (1.f + __expf(-x)), sng = 1.f / (1.f + __expf(x));
        Ls[lane] = cst0 + cst1 * sg;
        Ls[64 + lane] = cst1 * sng;
        Ls[128 + lane] = siluf_(pf[s][0]);
        Ls[192 + lane] = pf[s][2];
      }
    }
  };
  issue(0);
  for (int j0 = 0; j0 < T_; j0 += 8) {
    wave_lds_sync();
    commit();
    wave_lds_sync();
    if (j0 + 8 < T_) issue(j0 + 8);
#pragma unroll 1
    for (int s = 0; s < 8; ++s) {
      const float* Ls = L + s * 384;
      float o0 = 0.f, o1 = 0.f, o2 = 0.f, o3 = 0.f;
      if (MIX == 0) {
        float a0 = 0.f, a1 = 0.f, a2 = 0.f, a3 = 0.f;
#pragma unroll
        for (int q = 0; q < 16; ++q) {
          if ((q & 3) == 0) __builtin_amdgcn_sched_barrier(0);
          float4 k4 = ((const float4*)(Ls + 64))[q];
          a0 += S[4 * q] * k4.x; a1 += S[4 * q + 1] * k4.y; a2 += S[4 * q + 2] * k4.z; a3 += S[4 * q + 3] * k4.w;
        }
        const float nskk = -((a0 + a1) + (a2 + a3));
        const float vv = Ls[320 + lane];
#pragma unroll
        for (int q = 0; q < 16; ++q) {
          if ((q & 1) == 0) __builtin_amdgcn_sched_barrier(0);
          float4 w4 = ((const float4*)(Ls))[q];
          float4 ka4 = ((const float4*)(Ls + 128))[q];
          float4 kd4 = ((const float4*)(Ls + 192))[q];
          float4 r4 = ((const float4*)(Ls + 256))[q];
          float s0 = S[4 * q] * w4.x + nskk * ka4.x + vv * kd4.x;
          float s1 = S[4 * q + 1] * w4.y + nskk * ka4.y + vv * kd4.y;
          float s2 = S[4 * q + 2] * w4.z + nskk * ka4.z + vv * kd4.z;
          float s3 = S[4 * q + 3] * w4.w + nskk * ka4.w + vv * kd4.w;
          S[4 * q] = s0; S[4 * q + 1] = s1; S[4 * q + 2] = s2; S[4 * q + 3] = s3;
          o0 += s0 * r4.x; o1 += s1 * r4.y; o2 += s2 * r4.z; o3 += s3 * r4.w;
        }
      } else if (MIX == 1) {
        const float vv = Ls[128 + lane];
        const float gm = cst0;
#pragma unroll
        for (int q = 0; q < 16; ++q) {
          if ((q & 3) == 0) __builtin_amdgcn_sched_barrier(0);
          float4 q4 = ((const float4*)(Ls))[q];
          float4 k4 = ((const float4*)(Ls + 64))[q];
          float s0 = S[4 * q] * gm + k4.x * vv, s1 = S[4 * q + 1] * gm + k4.y * vv;
          float s2 = S[4 * q + 2] * gm + k4.z * vv, s3 = S[4 * q + 3] * gm + k4.w * vv;
          S[4 * q] = s0; S[4 * q + 1] = s1; S[4 * q + 2] = s2; S[4 * q + 3] = s3;
          o0 += s0 * q4.x; o1 += s1 * q4.y; o2 += s2 * q4.z; o3 += s3 * q4.w;
        }
      } else {
        const float vv = Ls[192 + lane];
#pragma unroll
        for (int q = 0; q < 16; ++q) {
          if ((q & 3) == 0) __builtin_amdgcn_sched_barrier(0);
          float4 f4 = ((const float4*)(Ls))[q];
          float4 k4 = ((const float4*)(Ls + 64))[q];
          float4 q4 = ((const float4*)(Ls + 128))[q];
          float s0 = S[4 * q] * f4.x + k4.x * vv, s1 = S[4 * q + 1] * f4.y + k4.y * vv;
          float s2 = S[4 * q + 2] * f4.z + k4.z * vv, s3 = S[4 * q + 3] * f4.w + k4.w * vv;
          S[4 * q] = s0; S[4 * q + 1] = s1; S[4 * q + 2] = s2; S[4 * q + 3] = s3;
          o0 += s0 * q4.x; o1 += s1 * q4.y; o2 += s2 * q4.z; o3 += s3 * q4.w;
        }
      }
      const int t = scan_tok(d, j0 + s);
      Y[((size_t)b * T_ + t) * 256 + c] = f2bf((o0 + o1) + (o2 + o3));
    }
  }
}

struct AttSmem {
  bf16_t k[64 * 72];
  bf16_t vt[64 * 72];
};

DEV void attn_task(const P& p, int l, int task, AttSmem* sm) {
  const int tid = threadIdx.x, lane = tid & 63, w = tid >> 6, r = lane & 31, h = lane >> 5;
  int b, hq, q0, nkeys;
  if (task < 1024) { b = task >> 6; hq = (task >> 4) & 3; q0 = NC_ + (task & 15) * 128; nkeys = T_; }
  else { int t2 = task - 1024; b = t2 >> 3; hq = (t2 >> 1) & 3; q0 = (t2 & 1) * 128; nkeys = NC_; }
  const int kvh = hq >> 1;
  const bf16_t* ATQ = (const bf16_t*)((const char*)p.out + OUT_ATQ);
  const bf16_t* ATK = (const bf16_t*)((const char*)p.out + OUT_ATK);
  bf16_t* ATO = (bf16_t*)((char*)p.out + OUT_ATO);
  const bf16_t* ZD = (const bf16_t*)(p.ws + OFF_ZD);
  const size_t qrow = (size_t)b * T_ + q0 + 32 * w + r;
  bf16x8 qf[4];
#pragma unroll
  for (int ks = 0; ks < 4; ++ks) qf[ks] = *(const bf16x8*)(ATQ + qrow * 256 + hq * 64 + 16 * ks + 8 * h);
  f32x16 O[2];
#pragma unroll
  for (int e = 0; e < 16; ++e) { O[0][e] = 0.f; O[1][e] = 0.f; }
  float m = -1e30f, lsum = 0.f;
  for (int kt = 0; kt < nkeys; kt += 64) {
    __syncthreads();
#pragma unroll
    for (int i = 0; i < 2; ++i) {
      int q = tid + 256 * i, key = q >> 3, dc = q & 7;
      size_t krow = (size_t)b * T_ + kt + key;
      uint4 kv = *(const uint4*)(ATK + krow * 128 + kvh * 64 + 8 * dc);
      *(uint4*)&sm->k[key * 72 + 8 * dc] = kv;
      uint4 vv = *(const uint4*)(ZD + krow * 512 + 384 + kvh * 64 + 8 * dc);
      const bf16_t* ve = (const bf16_t*)&vv;
#pragma unroll
      for (int e = 0; e < 8; ++e) sm->vt[(8 * dc + e) * 72 + key] = ve[e];
    }
    __syncthreads();
    f32x16 Sx[2];
#pragma unroll
    for (int kb = 0; kb < 2; ++kb) {
#pragma unroll
      for (int e = 0; e < 16; ++e) Sx[kb][e] = 0.f;
#pragma unroll
      for (int ks = 0; ks < 4; ++ks) {
        bf16x8 kf = *(const bf16x8*)&sm->k[(32 * kb + r) * 72 + 16 * ks + 8 * h];
        Sx[kb] = __builtin_amdgcn_mfma_f32_32x32x16_bf16(kf, qf[ks], Sx[kb], 0, 0, 0);
      }
    }
    float mx = -1e30f;
#pragma unroll
    for (int kb = 0; kb < 2; ++kb)
#pragma unroll
      for (int e = 0; e < 16; ++e) mx = fmaxf(mx, Sx[kb][e]);
    mx = fmaxf(mx, __shfl_xor(mx, 32, 64));
    const float mnew = fmaxf(m, mx);
    const float scale = __expf(m - mnew);
    m = mnew;
    float ps = 0.f;
#pragma unroll
    for (int kb = 0; kb < 2; ++kb)
#pragma unroll
      for (int e = 0; e < 16; ++e) {
        float pv = __expf(Sx[kb][e] - mnew);
        Sx[kb][e] = pv;
        ps += pv;
      }
    lsum = lsum * scale + ps;
#pragma unroll
    for (int e = 0; e < 16; ++e) { O[0][e] *= scale; O[1][e] *= scale; }
#pragma unroll
    for (int kb = 0; kb < 2; ++kb)
#pragma unroll
      for (int s = 0; s < 2; ++s) {
        bf16x8 pfrag;
#pragma unroll
        for (int j = 0; j < 8; ++j) pfrag[j] = (short)f2bf(Sx[kb][8 * s + j]);
#pragma unroll
        for (int dt = 0; dt < 2; ++dt) {
          const bf16_t* vp = &sm->vt[(32 * dt + r) * 72 + 32 * kb + 16 * s + 4 * h];
          uint2 lo = *(const uint2*)vp, hi = *(const uint2*)(vp + 8);
          bf16x8 vf;
          uint4 tmp; tmp.x = lo.x; tmp.y = lo.y; tmp.z = hi.x; tmp.w = hi.y;
          vf = *(bf16x8*)&tmp;
          O[dt] = __builtin_amdgcn_mfma_f32_32x32x16_bf16(vf, pfrag, O[dt], 0, 0, 0);
        }
      }
  }
  const float ltot = lsum + __shfl_xor(lsum, 32, 64);
  const float invl = 1.f / ltot;
#pragma unroll
  for (int dt = 0; dt < 2; ++dt)
#pragma unroll
    for (int g = 0; g < 4; ++g) {
      uint2 v;
      v.x = pack2(O[dt][4 * g] * invl, O[dt][4 * g + 1] * invl);
      v.y = pack2(O[dt][4 * g + 2] * invl, O[dt][4 * g + 3] * invl);
      *(uint2*)(ATO + qrow * 256 + hq * 64 + 32 * dt + 8 * g + 4 * h) = v;
    }
}

DEV void phase_scan(const P& p, int l, char* smem) {
  const int NSB = 128;
  if ((int)blockIdx.x < NSB) {
    const int wv = threadIdx.x >> 6;
    float* L = (float*)smem + wv * (8 * 384);
    if (wv == 0) scan_task<0>(p, l, blockIdx.x, L);
    else if (wv == 1) scan_task<1>(p, l, blockIdx.x, L);
    else if (wv == 2) scan_task<2>(p, l, blockIdx.x, L);
  } else {
    const int ntask = (l == 0) ? 1152 : 1024;
    for (int task = blockIdx.x - NSB; task < ntask; task += gridDim.x - NSB) attn_task(p, l, task, (AttSmem*)smem);
  }
}

DEV void phase_post(const P& p, int l, char* smem) {
  const int tid = threadIdx.x, c = tid;
  const bf16_t* Y0 = (const bf16_t*)(p.ws + OFF_Y0);
  const bf16_t* Y1 = (const bf16_t*)((const char*)p.out + OUT_Y1);
  const bf16_t* Y2 = (const bf16_t*)((const char*)p.out + OUT_Y2);
  const bf16_t* ATO = (const bf16_t*)((const char*)p.out + OUT_ATO);
  const bf16_t* ZB = (const bf16_t*)(p.ws + OFF_ZB);
  const bf16_t* ZC = (const bf16_t*)(p.ws + OFF_ZC);
  const bf16_t* RWG = (const bf16_t*)(p.ws + OFF_RWG);
  const bf16_t* RWBG = RWG + RWSZ;
  bf16_t* BR = (bf16_t*)(p.ws + OFF_BR);
  const float lng = p.in[16][l * 256 + c], lnb = p.in[17][l * 256 + c];
  const float rng = p.in[19][l * 256 + c], rnb = p.in[20][l * 256 + c];
  const float hng = p.in[22][l * 256 + c];
  const int nm = n_mrows(l);
  for (int mrow = blockIdx.x; mrow < nm; mrow += gridDim.x) {
    const size_t row = map_row(l, mrow);
    bf16_t* o = BR + (size_t)mrow * 1024;
    {
      float y = bf2f(Y0[row * 256 + c]) + bf2f(Y0[RWSZ + row * 256 + c]);
      float mean = wave_sum(y) * (1.f / 64.f);
      float dlt = y - mean;
      float var = wave_sum(dlt * dlt) * (1.f / 64.f);
      float yn = dlt * rsqrtf(var + 64e-5f) * lng + lnb;
      o[c] = f2bf(yn * bf2f(RWG[row * 256 + c]) + bf2f(RWBG[row * 256 + c]));
    }
    {
      float y = bf2f(Y1[row * 256 + c]) + bf2f(Y1[RWSZ + row * 256 + c]);
      float mean = wave_sum(y) * (1.f / 64.f);
      float dlt = y - mean;
      float var = wave_sum(dlt * dlt) * (1.f / 64.f);
      float yn = dlt * rsqrtf(var + 1e-5f) * rng + rnb;
      o[256 + c] = f2bf(yn * siluf_(bf2f(ZB[row * 1024 + 768 + c])));
    }
    {
      float y = bf2f(Y2[row * 256 + c]) + bf2f(Y2[RWSZ + row * 256 + c]);
      float ms = wave_sum(y * y) * (1.f / 64.f);
      float yn = y * rsqrtf(ms + 1e-6f) * hng;
      o[512 + c] = f2bf(yn * siluf_(bf2f(ZC[row * 1280 + 1024 + c])));
    }
    o[768 + c] = ATO[row * 256 + c];
  }
}

DEV void phase_merge(const P& p, int l, char* smem) {
  GemmSmem* sm = (GemmSmem*)smem;
  ACC_IDS
  {
    float4 z4 = make_float4(0.f, 0.f, 0.f, 0.f);
    float4* f1 = (float4*)p.out;
    const size_t n1 = (size_t)NB_ * NL_ * D_ / 4;
    for (size_t i = (size_t)blockIdx.x * 256 + tid; i < n1; i += (size_t)gridDim.x * 256) f1[i] = z4;
    float4* f2 = (float4*)(p.ws + OFF_FCTX);
    const size_t n2 = (size_t)NB_ * NC_ * D_ / 4;
    for (size_t i = (size_t)blockIdx.x * 256 + tid; i < n2; i += (size_t)gridDim.x * 256) f2[i] = z4;
  }
  const bf16_t* BR = (const bf16_t*)(p.ws + OFF_BR);
  bf16_t* MRG = (bf16_t*)(p.ws + OFF_MRG);
  const int ntile = (n_mrows(l) / 128) * 8;
  for (int tile = blockIdx.x; tile < ntile; tile += gridDim.x) {
    const int mt = tile >> 3, nt = tile & 7;
    f32x16 mer[2][2];
#pragma unroll
    for (int mi = 0; mi < 2; ++mi)
#pragma unroll
      for (int ni = 0; ni < 2; ++ni)
#pragma unroll
        for (int e = 0; e < 16; ++e) mer[mi][ni][e] = 0.f;
    for (int i = 0; i < 4; ++i) {
      ALModX al;
      ALBf ab;
#pragma unroll
      for (int q = 0; q < 2; ++q) {
        int mrow = mt * 128 + (tid >> 2) + 64 * q;
        int row = map_row(l, mrow);
        al.xp[q] = xin_row(p, l, row);
        al.mp[q] = mod_row(p, l, row);
        ab.ap[q] = BR + (size_t)mrow * 1024 + i * 256;
      }
      f32x16 ag[1][2][2], abr[1][2][2];
      acc_zero<1>(ag);
      acc_zero<1>(abr);
      gemm_core<1>(al, p.in[25] + ((size_t)(l * 4 + i)) * 1024 * 1024 + nt * 128, nullptr, 1024, 1024, sm, ag);
      gemm_core<1>(ab, p.in[26] + ((size_t)(l * 4 + i)) * 256 * 1024 + nt * 128, nullptr, 1024, 256, sm, abr);
#pragma unroll
      for (int mi = 0; mi < 2; ++mi)
#pragma unroll
        for (int ni = 0; ni < 2; ++ni)
#pragma unroll
          for (int e = 0; e < 16; ++e) mer[mi][ni][e] += sigmoidf_(ag[0][mi][ni][e]) * abr[0][mi][ni][e];
    }
#pragma unroll
    for (int mi = 0; mi < 2; ++mi)
#pragma unroll
      for (int ni = 0; ni < 2; ++ni)
#pragma unroll
        for (int e = 0; e < 16; ++e) {
          int mrow = mt * 128 + ACC_ROW(mi, e), col = nt * 128 + ACC_COL(ni);
          MRG[(size_t)mrow * 1024 + col] = f2bf(mer[mi][ni][e]);
        }
  }
}

DEV void phase_out(const P& p, int l, char* smem) {
  GemmSmem* sm = (GemmSmem*)smem;
  ACC_IDS
  const bf16_t* MRG = (const bf16_t*)(p.ws + OFF_MRG);
  float* XA = (float*)(p.ws + OFF_XA);
  const int ntile = (n_mrows(l) / 128) * 8;
  for (int tile = blockIdx.x; tile < ntile; tile += gridDim.x) {
    const int mt = tile >> 3, nt = tile & 7;
    ALBf ab;
#pragma unroll
    for (int q = 0; q < 2; ++q) ab.ap[q] = MRG + (size_t)(mt * 128 + (tid >> 2) + 64 * q) * 1024;
    f32x16 acc[1][2][2];
    acc_zero<1>(acc);
    gemm_core<1>(ab, p.in[27] + (size_t)l * 1024 * 1024 + nt * 128, nullptr, 1024, 1024, sm, acc);
#pragma unroll
    for (int mi = 0; mi < 2; ++mi)
#pragma unroll
      for (int e = 0; e < 16; ++e) {
        const int mrow = mt * 128 + ACC_ROW(mi, e);
        const int row = map_row(l, mrow);
        const float* xr = xin_row(p, l, row);
        const float* mr = mod_row(p, l, row);
#pragma unroll
        for (int ni = 0; ni < 2; ++ni) {
          int col = nt * 128 + ACC_COL(ni);
          XA[(size_t)row * D_ + col] = ALPHA * xr[col] + mr[2048 + col] * acc[0][mi][ni][e];
        }
      }
  }
}

DEV float block_sum(float v, float* red) {
  v = wave_sum(v);
  __syncthreads();
  if ((threadIdx.x & 63) == 0) red[threadIdx.x >> 6] = v;
  __syncthreads();
  return (red[0] + red[1]) + (red[2] + red[3]);
}

DEV void phase_ln1(const P& p, int l, char* smem) {
  float* red = (float*)smem;
  float* red16 = red + 16;
  const int tid = threadIdx.x, n = tid * 4;
  float* XA = (float*)(p.ws + OFF_XA);
  float* AFF = (float*)(p.ws + OFF_AFF);
  const float4 g4 = *(const float4*)(p.in[28] + l * 1024 + n), b4 = *(const float4*)(p.in[29] + l * 1024 + n);
  const float* WR = p.in[30] + (size_t)l * 1024 * 16;
  const int nm = n_mrows(l);
  for (int mrow = blockIdx.x; mrow < nm; mrow += gridDim.x) {
    const int row = map_row(l, mrow);
    float4 v = *(float4*)(XA + (size_t)row * D_ + n);
    float mean = block_sum((v.x + v.y) + (v.z + v.w), red) * (1.f / 1024.f);
    float4 dl = make_float4(v.x - mean, v.y - mean, v.z - mean, v.w - mean);
    float var = block_sum((dl.x * dl.x + dl.y * dl.y) + (dl.z * dl.z + dl.w * dl.w), red) * (1.f / 1024.f);
    float rs = rsqrtf(var + 1e-5f);
    float4 x1 = make_float4(dl.x * rs * g4.x + b4.x, dl.y * rs * g4.y + b4.y, dl.z * rs * g4.z + b4.z,
                            dl.w * rs * g4.w + b4.w);
    *(float4*)(XA + (size_t)row * D_ + n) = x1;
    const float* mr = mod_row(p, l, row);
    float4 sh = *(const float4*)(mr + 3072 + n), scv = *(const float4*)(mr + 4096 + n);
    float u[4] = {x1.x * (1.f + scv.x) + sh.x, x1.y * (1.f + scv.y) + sh.y, x1.z * (1.f + scv.z) + sh.z,
                  x1.w * (1.f + scv.w) + sh.w};
    float lg[16];
#pragma unroll
    for (int e = 0; e < 16; ++e) lg[e] = 0.f;
#pragma unroll
    for (int i = 0; i < 4; ++i) {
      const float4* wr = (const float4*)(WR + (size_t)(n + i) * 16);
#pragma unroll
      for (int q = 0; q < 4; ++q) {
        float4 w4 = wr[q];
        lg[4 * q] += u[i] * w4.x; lg[4 * q + 1] += u[i] * w4.y; lg[4 * q + 2] += u[i] * w4.z; lg[4 * q + 3] += u[i] * w4.w;
      }
    }
#pragma unroll
    for (int e = 0; e < 16; ++e) lg[e] = wave_sum(lg[e]);
    __syncthreads();
    if ((tid & 63) == 0) {
#pragma unroll
      for (int e = 0; e < 16; ++e) red16[(tid >> 6) * 16 + e] = lg[e];
    }
    __syncthreads();
    if (tid < 16) {
      float mine = (red16[tid] + red16[16 + tid]) + (red16[32 + tid] + red16[48 + tid]);
      float mx = mine;
#pragma unroll
      for (int o = 8; o > 0; o >>= 1) mx = fmaxf(mx, __shfl_xor(mx, o, 16));
      float ex = __expf(mine - mx);
      float sm = ex;
#pragma unroll
      for (int o = 8; o > 0; o >>= 1) sm += __shfl_xor(sm, o, 16);
      const int b = row / T_, t = row - b * T_;
      AFF[((size_t)(b * 16 + tid)) * T_ + t] = ex / sm;
    }
  }
}

DEV void phase_topk(const P& p, int l, char* smem) {
  u64* keys = (u64*)smem;
  const int tid = threadIdx.x;
  const float* AFF = (const float*)(p.ws + OFF_AFF);
  int* IDX = (int*)(p.ws + OFF_IDX);
  float* GATE = (float*)(p.ws + OFF_GATE);
  const int ntask = (l == 0) ? 512 : 256;
  for (int task = blockIdx.x; task < ntask; task += gridDim.x) {
    const int seg = task >> 8, be = task & 255;
    const int n = seg ? NC_ : NL_, t0 = seg ? 0 : NC_, cap = seg ? 32 : 256;
    const float* aff = AFF + (size_t)be * T_ + t0;
    __syncthreads();
    for (int i = tid; i < 2048; i += 256)
      keys[i] = (i < n) ? (((u64)__float_as_uint(aff[i]) << 32) | (u64)(0xFFFFFFFFu - (unsigned)i)) : 0ull;
    __syncthreads();
    for (int k = 2; k <= 2048; k <<= 1)
      for (int j = k >> 1; j > 0; j >>= 1) {
        for (int i = tid; i < 2048; i += 256) {
          int ixj = i ^ j;
          if (ixj > i) {
            u64 a = keys[i], bb = keys[ixj];
            bool desc = ((i & k) == 0);
            if (desc ? (a < bb) : (a > bb)) { keys[i] = bb; keys[ixj] = a; }
          }
        }
        __syncthreads();
      }
    for (int i = tid; i < cap; i += 256) {
      u64 kv = keys[i];
      IDX[be * 288 + seg * 256 + i] = (int)(0xFFFFFFFFu - (unsigned)(kv & 0xFFFFFFFFull));
      GATE[be * 288 + seg * 256 + i] = __uint_as_float((unsigned)(kv >> 32));
    }
  }
}

DEV void slot_info(const P& p, int e, int mtile, int rr, int& row, float& gate, int& seg, int& b, int& idx) {
  const int* IDX = (const int*)(p.ws + OFF_IDX);
  const float* GATE = (const float*)(p.ws + OFF_GATE);
  if (mtile < 32) {
    int slot = mtile * 128 + rr;
    b = slot >> 8;
    int j = slot & 255;
    idx = IDX[(b * 16 + e) * 288 + j];
    gate = GATE[(b * 16 + e) * 288 + j];
    seg = 0;
    row = b * T_ + NC_ + idx;
  } else {
    int slot = (mtile - 32) * 128 + rr;
    b = slot >> 5;
    int j = slot & 31;
    idx = IDX[(b * 16 + e) * 288 + 256 + j];
    gate = GATE[(b * 16 + e) * 288 + 256 + j];
    seg = 1;
    row = b * T_ + idx;
  }
}

DEV void phase_eup(const P& p, int l, char* smem) {
  GemmSmem* sm = (GemmSmem*)smem;
  ACC_IDS
  const float* XA = (const float*)(p.ws + OFF_XA);
  bf16_t* H = (bf16_t*)(p.ws + OFF_H);
  const int MT = (l == 0) ? 36 : 32;
  const int ntile = 16 * MT * 8;
  for (int tile = blockIdx.x; tile < ntile; tile += gridDim.x) {
    const int nt = tile & 7, mt = (tile >> 3) % MT, e = (tile >> 3) / MT;
    ALModX al;
#pragma unroll
    for (int q = 0; q < 2; ++q) {
      int row, seg, b, idx;
      float gate;
      slot_info(p, e, mt, (tid >> 2) + 64 * q, row, gate, seg, b, idx);
      al.xp[q] = XA + (size_t)row * D_;
      al.mp[q] = mod_row(p, l, row) + 3072;
    }
    f32x16 acc[2][2][2];
    acc_zero<2>(acc);
    const size_t wo = ((size_t)(l * 16 + e)) * 1024 * 1024 + nt * 128;
    gemm_core<2>(al, p.in[31] + wo, p.in[32] + wo, 1024, 1024, sm, acc);
#pragma unroll
    for (int mi = 0; mi < 2; ++mi)
#pragma unroll
      for (int ni = 0; ni < 2; ++ni)
#pragma unroll
        for (int q = 0; q < 16; ++q) {
          int hr = (e * 36 + mt) * 128 + ACC_ROW(mi, q), col = nt * 128 + ACC_COL(ni);
          H[(size_t)hr * 1024 + col] = f2bf(siluf_(acc[0][mi][ni][q]) * acc[1][mi][ni][q]);
        }
  }
}

DEV void phase_edown(const P& p, int l, char* smem) {
  GemmSmem* sm = (GemmSmem*)smem;
  ACC_IDS
  const bf16_t* H = (const bf16_t*)(p.ws + OFF_H);
  float* FL = p.out;
  float* FC = (float*)(p.ws + OFF_FCTX);
  const int MT = (l == 0) ? 36 : 32;
  const int ntile = 16 * MT * 8;
  for (int tile = blockIdx.x; tile < ntile; tile += gridDim.x) {
    const int nt = tile & 7, mt = (tile >> 3) % MT, e = (tile >> 3) / MT;
    ALBf ab;
#pragma unroll
    for (int q = 0; q < 2; ++q) ab.ap[q] = H + (size_t)((e * 36 + mt) * 128 + (tid >> 2) + 64 * q) * 1024;
    f32x16 acc[1][2][2];
    acc_zero<1>(acc);
    gemm_core<1>(ab, p.in[33] + ((size_t)(l * 16 + e)) * 1024 * 1024 + nt * 128, nullptr, 1024, 1024, sm, acc);
#pragma unroll
    for (int mi = 0; mi < 2; ++mi)
#pragma unroll
      for (int q = 0; q < 16; ++q) {
        int row, seg, b, idx;
        float gate;
        slot_info(p, e, mt, ACC_ROW(mi, q), row, gate, seg, b, idx);
        float* dst = seg ? (FC + ((size_t)(b * NC_ + idx)) * D_) : (FL + ((size_t)(b * NL_ + idx)) * D_);
#pragma unroll
        for (int ni = 0; ni < 2; ++ni) unsafeAtomicAdd(dst + nt * 128 + ACC_COL(ni), gate * acc[0][mi][ni][q]);
      }
  }
}

DEV void phase_ln2(const P& p, int l, char* smem) {
  float* red = (float*)smem;
  const int tid = threadIdx.x, n = tid * 4;
  float* XA = (float*)(p.ws + OFF_XA);
  const float* FC = (const float*)(p.ws + OFF_FCTX);
  const float4 g4 = *(const float4*)(p.in[34] + l * 1024 + n), b4 = *(const float4*)(p.in[35] + l * 1024 + n);
  const int nm = n_mrows(l);
  for (int mrow = blockIdx.x; mrow < nm; mrow += gridDim.x) {
    const int row = map_row(l, mrow);
    const int b = row / T_, t = row - b * T_;
    const float* mr = mod_row(p, l, row);
    float4 x1 = *(const float4*)(XA + (size_t)row * D_ + n);
    float* fp = (t < NC_) ? (float*)(FC + ((size_t)(b * NC_ + t)) * D_ + n) : (p.out + ((size_t)(b * NL_ + t - NC_)) * D_ + n);
    float4 f = *(const float4*)fp;
    float4 g2 = *(const float4*)(mr + 5120 + n);
    float4 v = make_float4(ALPHA * x1.x + g2.x * f.x, ALPHA * x1.y + g2.y * f.y, ALPHA * x1.z + g2.z * f.z,
                           ALPHA * x1.w + g2.w * f.w);
    float mean = block_sum((v.x + v.y) + (v.z + v.w), red) * (1.f / 1024.f);
    float4 dl = make_float4(v.x - mean, v.y - mean, v.z - mean, v.w - mean);
    float var = block_sum((dl.x * dl.x + dl.y * dl.y) + (dl.z * dl.z + dl.w * dl.w), red) * (1.f / 1024.f);
    float rs = rsqrtf(var + 1e-5f);
    float4 o = make_float4(dl.x * rs * g4.x + b4.x, dl.y * rs * g4.y + b4.y, dl.z * rs * g4.z + b4.z,
                           dl.w * rs * g4.w + b4.w);
    if (l == 0) *(float4*)(XA + (size_t)row * D_ + n) = o;
    else *(float4*)fp = o;
  }
}

constexpr int NPHASE = 23;
DEV void run_phase(const P& p, int ph, char* smem) {
  if (ph == 0) { phase_mod(p, smem); return; }
  const int l = (ph - 1) / 11, k = (ph - 1) % 11;
  switch (k) {
    case 0: phase_in(p, l, smem); break;
    case 1: phase_prep(p, l, smem); break;
    case 2: phase_scan(p, l, smem); break;
    case 3: phase_post(p, l, smem); break;
    case 4: phase_merge(p, l, smem); break;
    case 5: phase_out(p, l, smem); break;
    case 6: phase_ln1(p, l, smem); break;
    case 7: phase_topk(p, l, smem); break;
    case 8: phase_eup(p, l, smem); break;
    case 9: phase_edown(p, l, smem); break;
    default: phase_ln2(p, l, smem); break;
  }
}

#ifdef USE_MEGA
__global__ void __launch_bounds__(256) mega(P p, int ph_lo, int ph_hi) {
  __shared__ __attribute__((aligned(16))) char smem[49152];
  cg::grid_group grid = cg::this_grid();
  for (int ph = ph_lo; ph < ph_hi; ++ph) {
    if (ph > ph_lo) grid.sync();
    run_phase(p, ph, smem);
  }
}

#endif
template <int K>
__global__ void __launch_bounds__(256) phase_kernel(P p, int l) {
  __shared__ __attribute__((aligned(16))) char smem[49152];
  if (K == -1) phase_mod(p, smem);
  if (K == 0) phase_in(p, l, smem);
  if (K == 1) phase_prep(p, l, smem);
  if (K == 2) phase_scan(p, l, smem);
  if (K == 3) phase_post(p, l, smem);
  if (K == 4) phase_merge(p, l, smem);
  if (K == 5) phase_out(p, l, smem);
  if (K == 6) phase_ln1(p, l, smem);
  if (K == 7) phase_topk(p, l, smem);
  if (K == 8) phase_eup(p, l, smem);
  if (K == 9) phase_edown(p, l, smem);
  if (K == 10) phase_ln2(p, l, smem);
}

extern "C" void kernel_launch(void* const* d_in, const int* in_sizes, int n_in, void* d_out, int out_size,
                              void* d_ws, size_t ws_size, hipStream_t stream) {
  static int grid_blocks = 0;
  if (!grid_blocks) {
    int dev = 0, cus = 0, per_cu = 0;
    hipGetDevice(&dev);
    hipDeviceGetAttribute(&cus, hipDeviceAttributeMultiprocessorCount, dev);
    per_cu = 2;
    if (per_cu > 2) per_cu = 2;
    if (per_cu < 1) per_cu = 1;
    grid_blocks = cus * per_cu;
  }
  P p{};
  for (int i = 0; i < 36; ++i) p.in[i] = (const float*)d_in[i];
  p.out = (float*)d_out;
  p.ws = (char*)d_ws;
  if (ws_size < WS_NEED) fprintf(stderr, "workspace too small: %zu < %zu\n", ws_size, WS_NEED);
#if 1
  const dim3 g(grid_blocks), bk(256);
  hipLaunchKernelGGL(phase_kernel<-1>, g, bk, 0, stream, p, 0);
  for (int l = 0; l < 2; ++l) {
    hipLaunchKernelGGL(phase_kernel<0>, g, bk, 0, stream, p, l);
    hipLaunchKernelGGL(phase_kernel<1>, g, bk, 0, stream, p, l);
    hipLaunchKernelGGL(phase_kernel<2>, g, bk, 0, stream, p, l);
    hipLaunchKernelGGL(phase_kernel<3>, g, bk, 0, stream, p, l);
    hipLaunchKernelGGL(phase_kernel<4>, g, bk, 0, stream, p, l);
    hipLaunchKernelGGL(phase_kernel<5>, g, bk, 0, stream, p, l);
    hipLaunchKernelGGL(phase_kernel<6>, g, bk, 0, stream, p, l);
    hipLaunchKernelGGL(phase_kernel<7>, g, bk, 0, stream, p, l);
    hipLaunchKernelGGL(phase_kernel<8>, g, bk, 0, stream, p, l);
    hipLaunchKernelGGL(phase_kernel<9>, g, bk, 0, stream, p, l);
    hipLaunchKernelGGL(phase_kernel<10>, g, bk, 0, stream, p, l);
  }
#else

#endif
}
```

```cpp
#include <hip/hip_runtime.h>
#include <hip/hip_cooperative_groups.h>
#include <stdint.h>
#include <stdio.h>
namespace cg = cooperative_groups;

typedef unsigned short bf16_t;
using bf16x8 = __attribute__((ext_vector_type(8))) short;
using f32x16 = __attribute__((ext_vector_type(16))) float;
typedef unsigned long long u64;
#define DEV __device__ __forceinline__

constexpr int NB_ = 16, T_ = 2304, NC_ = 256, NL_ = 2048, D_ = 1024, ROWS_ = NB_ * T_;
constexpr float ALPHA = 1.41421356237309515f;
constexpr size_t MiB = 1ull << 20;
constexpr size_t OFF_MOD = 0, OFF_COS = 1 * MiB, OFF_SIN = 1 * MiB + 262144, OFF_AFF = 2 * MiB,
                 OFF_IDX = 5 * MiB, OFF_GATE = 5 * MiB + 512 * 1024;
constexpr size_t OFF_XA = 6 * MiB, OFF_ZA = 150 * MiB, OFF_ZB = 231 * MiB, OFF_ZC = 303 * MiB, OFF_ZD = 393 * MiB,
                 OFF_RWW = 429 * MiB, OFF_RWA = 501 * MiB, OFF_RWR = 537 * MiB, OFF_RWG = 609 * MiB;
constexpr size_t WS_NEED = 645 * MiB;
constexpr size_t OFF_CNT = 1 * MiB - 256;
constexpr size_t OFF_BAR = 900 * 1024;
constexpr size_t OFF_LW = 1 * MiB + 512 * 1024;
constexpr size_t OFF_SCH = 4 * MiB + 512 * 1024;
constexpr size_t OFF_WINT = OFF_RWW;
constexpr size_t OFF_WGT = OFF_ZA + 40 * MiB;
constexpr size_t OFF_WBT = OFF_WGT + 8 * MiB;
constexpr size_t OFF_WOT = OFF_WBT + 2 * MiB;
constexpr size_t OFF_U = OFF_RWR;
constexpr size_t OFF_TCNT = OFF_RWG;
constexpr size_t OFF_TLIST = OFF_RWG + 1 * MiB;
constexpr size_t OFF_WINT1 = 480 * MiB;
constexpr size_t OFF_YEXP = 335 * MiB;
constexpr size_t OFF_XS = 400 * MiB;
constexpr size_t OFF_WE2T = OFF_ZC, OFF_WE1T = OFF_ZC + 32 * MiB, OFF_WE3T = OFF_ZC + 64 * MiB;
constexpr int SMEM_BYTES = 73728 + 16;
constexpr size_t OFF_Y0 = OFF_ZA, OFF_H = OFF_ZA, OFF_BR = OFF_RWW, OFF_MRG = OFF_RWR, OFF_FCTX = OFF_RWG;
constexpr size_t OUT_Y1 = 0, OUT_Y2 = 36 * MiB, OUT_ATQ = 72 * MiB, OUT_ATK = 90 * MiB, OUT_ATO = 99 * MiB;
constexpr size_t RWSZ = (size_t)ROWS_ * 256;

struct P {
  const float* in[36];
  float* out;
  char* ws;
};

DEV int opaque_tid() {
  int t = threadIdx.x;
  asm volatile("" : "+v"(t));
  return t;
}
DEV float bf2f(bf16_t v) { return __uint_as_float(((unsigned)v) << 16); }
typedef float f2_t __attribute__((ext_vector_type(2)));
typedef __bf16 b2_t __attribute__((ext_vector_type(2)));
DEV unsigned pack2(float a, float b) {
  f2_t v = {a, b};
  b2_t r = __builtin_convertvector(v, b2_t);
  return __builtin_bit_cast(unsigned, r);
}
DEV bf16_t f2bf(float f) { return (bf16_t)(pack2(f, 0.f) & 0xFFFFu); }
DEV float sigmoidf_(float x) { return 1.f / (1.f + __expf(-x)); }
DEV float siluf_(float x) { return x / (1.f + __expf(-x)); }
DEV float dpp_add_(float v, const int ctrl_sel) {
  int x = __float_as_int(v);
  int y = (ctrl_sel == 0)   ? __builtin_amdgcn_update_dpp(0, x, 0xB1, 0xF, 0xF, true)
          : (ctrl_sel == 1) ? __builtin_amdgcn_update_dpp(0, x, 0x4E, 0xF, 0xF, true)
          : (ctrl_sel == 2) ? __builtin_amdgcn_update_dpp(0, x, 0x141, 0xF, 0xF, true)
                            : __builtin_amdgcn_update_dpp(0, x, 0x140, 0xF, 0xF, true);
  return v + __int_as_float(y);
}
DEV float wave_sum(float v) {
  v = dpp_add_(v, 0);
  v = dpp_add_(v, 1);
  v = dpp_add_(v, 2);
  v = dpp_add_(v, 3);
  const int x = __float_as_int(v);
  const float s0 = __int_as_float(__builtin_amdgcn_readlane(x, 0)), s1 = __int_as_float(__builtin_amdgcn_readlane(x, 16));
  const float s2 = __int_as_float(__builtin_amdgcn_readlane(x, 32)), s3 = __int_as_float(__builtin_amdgcn_readlane(x, 48));
  return (s0 + s1) + (s2 + s3);
}
DEV float reduce8(float v) {
  v = dpp_add_(v, 0);
  v = dpp_add_(v, 1);
  v = dpp_add_(v, 2);
  return v;
}
DEV float reduce16(float v) { return dpp_add_(reduce8(v), 3); }
DEV void unpack8(const uint4& u, float (&f)[8]) {
  f[0] = __uint_as_float(u.x << 16); f[1] = __uint_as_float(u.x & 0xFFFF0000u);
  f[2] = __uint_as_float(u.y << 16); f[3] = __uint_as_float(u.y & 0xFFFF0000u);
  f[4] = __uint_as_float(u.z << 16); f[5] = __uint_as_float(u.z & 0xFFFF0000u);
  f[6] = __uint_as_float(u.w << 16); f[7] = __uint_as_float(u.w & 0xFFFF0000u);
}
DEV uint4 pack8(const float (&f)[8]) {
  uint4 u;
  u.x = pack2(f[0], f[1]); u.y = pack2(f[2], f[3]); u.z = pack2(f[4], f[5]); u.w = pack2(f[6], f[7]);
  return u;
}
DEV void ld8f(const float* p, float (&f)[8]) {
  float4 a = *(const float4*)p, b = *(const float4*)(p + 4);
  f[0] = a.x; f[1] = a.y; f[2] = a.z; f[3] = a.w; f[4] = b.x; f[5] = b.y; f[6] = b.z; f[7] = b.w;
}
DEV float f4c(const float4& v, int c) { return c == 0 ? v.x : (c == 1 ? v.y : (c == 2 ? v.z : v.w)); }

DEV const float* xin_row(const P& p, int l, int row) {
  if (l == 0) {
    int b = row / T_, t = row - b * T_;
    return t < NC_ ? p.in[2] + ((size_t)(b * NC_ + t)) * D_ : p.in[0] + ((size_t)(b * NL_ + t - NC_)) * D_;
  }
  return (const float*)(p.ws + OFF_XA) + (size_t)row * D_;
}
DEV const float* mod_row(const P& p, int l, int row) {
  int b = row / T_, t = row - b * T_;
  return (const float*)(p.ws + OFF_MOD) + (size_t)(l * 17 + (t < NC_ ? 16 : b)) * 6144;
}
DEV bf16_t* u2_row(const P& p, int row) {
  return (row < 18432) ? (bf16_t*)(p.ws + OFF_ZD) + (size_t)row * D_ : (bf16_t*)(p.ws + OFF_RWA) + (size_t)(row - 18432) * D_;
}
DEV int map_row(int l, int mrow) { return l == 0 ? mrow : (mrow >> 11) * T_ + NC_ + (mrow & 2047); }
DEV int n_mrows(int l) { return l == 0 ? ROWS_ : NB_ * NL_; }

DEV void conv_tile(const float* src, bf16_t* dst, int K, int N, int nmat, int t, float* lds, const int tid) {
  const int tn = N >> 6, tpm = (K >> 6) * tn;
  const int m = t / tpm, rem = t - m * tpm, k0 = (rem / tn) << 6, n0 = (rem % tn) << 6;
  const float* S = src + (size_t)m * K * N;
  bf16_t* Dd = dst + (size_t)m * K * N;
  __syncthreads();
#pragma unroll
  for (int ps = 0; ps < 4; ++ps) {
    int kr = (tid >> 4) + 16 * ps, nq = tid & 15;
    float4 v = *(const float4*)(S + (size_t)(k0 + kr) * N + n0 + 4 * nq);
    float* d = lds + kr * 65 + 4 * nq;
    d[0] = v.x; d[1] = v.y; d[2] = v.z; d[3] = v.w;
  }
  __syncthreads();
#pragma unroll
  for (int ps = 0; ps < 2; ++ps) {
    int c = tid + 256 * ps, n = c >> 3, kc = c & 7;
    const float* sp = lds + (8 * kc) * 65 + n;
    uint4 o;
    o.x = pack2(sp[0], sp[65]);
    o.y = pack2(sp[2 * 65], sp[3 * 65]);
    o.z = pack2(sp[4 * 65], sp[5 * 65]);
    o.w = pack2(sp[6 * 65], sp[7 * 65]);
    *(uint4*)(Dd + (size_t)(n0 + n) * K + k0 + 8 * kc) = o;
  }
}
DEV void conv_batch(const float* src, bf16_t* dst, int K, int N, int nmat, float* lds, const int tid) {
  const int nt = nmat * (K >> 6) * (N >> 6);
  for (int t = blockIdx.x; t < nt; t += gridDim.x) conv_tile(src, dst, K, N, nmat, t, lds, tid);
}

struct GemmSmem {
  bf16_t a[2][128 * 40];
  bf16_t b[2][2][128 * 40];
};

typedef unsigned u4v __attribute__((ext_vector_type(4)));
typedef float f4v __attribute__((ext_vector_type(4)));
struct ALModX {
  const float* xp[2];
  const float* mp[2];
  struct Raw { f4v x00, x01, x10, x11, h0, h1, s0, s1; };
  template <int MI>
  DEV void issue(int k, Raw& rw) const {
    rw.h0 = *(const f4v*)(mp[0] + k); rw.h1 = *(const f4v*)(mp[0] + k + 4);
    rw.s0 = *(const f4v*)(mp[0] + 1024 + k); rw.s1 = *(const f4v*)(mp[0] + 1024 + k + 4);
    rw.x00 = *(const f4v*)(xp[0] + k); rw.x01 = *(const f4v*)(xp[0] + k + 4);
    if (MI > 1) { rw.x10 = *(const f4v*)(xp[1] + k); rw.x11 = *(const f4v*)(xp[1] + k + 4); }
  }
  DEV u4v cvt(const f4v& x0, const f4v& x1, const Raw& rw) const {
    u4v o;
    o.x = pack2(x0.x * (1.f + rw.s0.x) + rw.h0.x, x0.y * (1.f + rw.s0.y) + rw.h0.y);
    o.y = pack2(x0.z * (1.f + rw.s0.z) + rw.h0.z, x0.w * (1.f + rw.s0.w) + rw.h0.w);
    o.z = pack2(x1.x * (1.f + rw.s1.x) + rw.h1.x, x1.y * (1.f + rw.s1.y) + rw.h1.y);
    o.w = pack2(x1.z * (1.f + rw.s1.z) + rw.h1.z, x1.w * (1.f + rw.s1.w) + rw.h1.w);
    return o;
  }
  template <int MI>
  DEV void finish(const Raw& rw, u4v& a0, u4v& a1) const {
    a0 = cvt(rw.x00, rw.x01, rw);
    if (MI > 1) a1 = cvt(rw.x10, rw.x11, rw);
  }
};
struct ALBf {
  const bf16_t* ap[2];
  struct Raw { u4v v0, v1; };
  template <int MI>
  DEV void issue(int k, Raw& rw) const {
    rw.v0 = *(const u4v*)(ap[0] + k);
    if (MI > 1) rw.v1 = *(const u4v*)(ap[1] + k);
  }
  template <int MI>
  DEV void finish(const Raw& rw, u4v& a0, u4v& a1) const {
    a0 = rw.v0;
    if (MI > 1) a1 = rw.v1;
  }
};

struct ALBfIdx {
  const bf16_t* base;
  unsigned off[2];
  struct Raw { u4v v0, v1; };
  template <int MI>
  DEV void issue(int k, Raw& rw) const {
    rw.v0 = *(const u4v*)(base + (off[0] + (unsigned)k));
    if (MI > 1) rw.v1 = *(const u4v*)(base + (off[1] + (unsigned)k));
  }
  template <int MI>
  DEV void finish(const Raw& rw, u4v& a0, u4v& a1) const {
    a0 = rw.v0;
    if (MI > 1) a1 = rw.v1;
  }
};

template <int NBM, int MI, class AL>
DEV void gemm_core(const AL& al, const bf16_t* B0, const bf16_t* B1, int ldb, int K, GemmSmem* sm,
                   f32x16 (&acc)[NBM][MI][2], const int tid) {
  const int lane = tid & 63, w = tid >> 6, wm = w >> 1, wn = w & 1, r = lane & 31, h = lane >> 5;
  typedef typename AL::Raw RawT;
  struct RB { u4v b0, b1, b2, b3; };
  RawT rawA, rawB;
  RB rbA, rbB;
  const bf16_t* Bp0 = B0 + (size_t)(tid >> 2) * ldb + 8 * (tid & 3);
  const bf16_t* Bp1 = (NBM > 1) ? (B1 + (size_t)(tid >> 2) * ldb + 8 * (tid & 3)) : Bp0;
  const size_t bstep = (size_t)64 * ldb;
  auto gload = [&](int k0, RawT& raw, RB& rb) __attribute__((always_inline)) {
    al.template issue<MI>(k0 + 8 * (tid & 3), raw);
    rb.b0 = *(const u4v*)(Bp0 + k0);
    rb.b1 = *(const u4v*)(Bp0 + k0 + bstep);
    if (NBM > 1) {
      rb.b2 = *(const u4v*)(Bp1 + k0);
      rb.b3 = *(const u4v*)(Bp1 + k0 + bstep);
    }
  };
  auto lstore = [&](int buf, const RawT& raw, const RB& rb) __attribute__((always_inline)) {
    u4v a0, a1;
    al.template finish<MI>(raw, a0, a1);
    const int o0 = (tid >> 2) * 40 + 8 * (tid & 3), o1 = o0 + 64 * 40;
    *(u4v*)&sm->a[buf][o0] = a0;
    if (MI > 1) *(u4v*)&sm->a[buf][o1] = a1;
    *(u4v*)&sm->b[buf][0][o0] = rb.b0;
    *(u4v*)&sm->b[buf][0][o1] = rb.b1;
    if (NBM > 1) {
      *(u4v*)&sm->b[buf][1][o0] = rb.b2;
      *(u4v*)&sm->b[buf][1][o1] = rb.b3;
    }
  };
  auto compute = [&](int buf) __attribute__((always_inline)) {
#pragma unroll
    for (int ks = 0; ks < 2; ++ks) {
      bf16x8 af[MI], bfr[NBM][2];
#pragma unroll
      for (int mi = 0; mi < MI; ++mi)
        af[mi] = *(const bf16x8*)&sm->a[buf][(32 * MI * wm + 32 * mi + r) * 40 + ks * 16 + 8 * h];
#pragma unroll
      for (int nb = 0; nb < NBM; ++nb)
#pragma unroll
        for (int ni = 0; ni < 2; ++ni)
          bfr[nb][ni] = *(const bf16x8*)&sm->b[buf][nb][(64 * wn + 32 * ni + r) * 40 + ks * 16 + 8 * h];
#pragma unroll
      for (int nb = 0; nb < NBM; ++nb)
#pragma unroll
        for (int mi = 0; mi < MI; ++mi)
#pragma unroll
          for (int ni = 0; ni < 2; ++ni)
            acc[nb][mi][ni] = __builtin_amdgcn_mfma_f32_32x32x16_bf16(af[mi], bfr[nb][ni], acc[nb][mi][ni], 0, 0, 0);
    }
  };
  const int KT = K >> 5;
  const int klast = K - 32;
  gload(0, rawA, rbA);
  gload(32, rawB, rbB);
  lstore(0, rawA, rbA);
  __syncthreads();
  for (int kt = 0; kt < KT; kt += 2) {
    gload(min((kt + 2) << 5, klast), rawA, rbA);
    compute(0);
    lstore(1, rawB, rbB);
    __syncthreads();
    gload(min((kt + 3) << 5, klast), rawB, rbB);
    compute(1);
    lstore(0, rawA, rbA);
    __syncthreads();
  }
}

struct GemmSmem64 {
  bf16_t a[2][128 * 72];
  bf16_t b[2][128 * 72];
};
template <int MI>
DEV void gemm64(const bf16_t* const (&ap)[4], const bf16_t* B, int ldb, int K, GemmSmem64* sm, f32x16 (&acc)[1][MI][2],
                const int tid) {
  const int lane = tid & 63, w = tid >> 6, wm = w >> 1, wn = w & 1, r = lane & 31, h = lane >> 5;
  struct St { u4v a0, a1, a2, a3, b0, b1, b2, b3; };
  St sA, sB;
  const int kc8 = 8 * (tid & 7);
  const bf16_t* Bp = B + (size_t)(tid >> 3) * ldb + kc8;
  const size_t bstep = (size_t)32 * ldb;
  auto gload = [&](int k0, St& st) __attribute__((always_inline)) {
    st.a0 = *(const u4v*)(ap[0] + k0 + kc8);
    st.a1 = *(const u4v*)(ap[1] + k0 + kc8);
    if (MI > 1) {
      st.a2 = *(const u4v*)(ap[2] + k0 + kc8);
      st.a3 = *(const u4v*)(ap[3] + k0 + kc8);
    }
    st.b0 = *(const u4v*)(Bp + k0);
    st.b1 = *(const u4v*)(Bp + k0 + bstep);
    st.b2 = *(const u4v*)(Bp + k0 + 2 * bstep);
    st.b3 = *(const u4v*)(Bp + k0 + 3 * bstep);
  };
  auto lstore = [&](int buf, const St& st) __attribute__((always_inline)) {
    const int o0 = (tid >> 3) * 72 + kc8;
    *(u4v*)&sm->a[buf][o0] = st.a0;
    *(u4v*)&sm->a[buf][o0 + 32 * 72] = st.a1;
    if (MI > 1) {
      *(u4v*)&sm->a[buf][o0 + 64 * 72] = st.a2;
      *(u4v*)&sm->a[buf][o0 + 96 * 72] = st.a3;
    }
    *(u4v*)&sm->b[buf][o0] = st.b0;
    *(u4v*)&sm->b[buf][o0 + 32 * 72] = st.b1;
    *(u4v*)&sm->b[buf][o0 + 64 * 72] = st.b2;
    *(u4v*)&sm->b[buf][o0 + 96 * 72] = st.b3;
  };
  auto compute = [&](int buf) __attribute__((always_inline)) {
#pragma unroll
    for (int ks = 0; ks < 4; ++ks) {
      bf16x8 af[MI], bfr[2];
#pragma unroll
      for (int mi = 0; mi < MI; ++mi)
        af[mi] = *(const bf16x8*)&sm->a[buf][(32 * MI * wm + 32 * mi + r) * 72 + ks * 16 + 8 * h];
#pragma unroll
      for (int ni = 0; ni < 2; ++ni) bfr[ni] = *(const bf16x8*)&sm->b[buf][(64 * wn + 32 * ni + r) * 72 + ks * 16 + 8 * h];
#pragma unroll
      for (int mi = 0; mi < MI; ++mi)
#pragma unroll
        for (int ni = 0; ni < 2; ++ni)
          acc[0][mi][ni] = __builtin_amdgcn_mfma_f32_32x32x16_bf16(af[mi], bfr[ni], acc[0][mi][ni], 0, 0, 0);
    }
  };
  const int KT = K >> 6;
  const int klast = K - 64;
  gload(0, sA);
  gload(64, sB);
  lstore(0, sA);
  __syncthreads();
  for (int kt = 0; kt < KT; kt += 2) {
    gload(min((kt + 2) << 6, klast), sA);
    compute(0);
    lstore(1, sB);
    __syncthreads();
    gload(min((kt + 3) << 6, klast), sB);
    compute(1);
    lstore(0, sA);
    __syncthreads();
  }
}

template <int NBM, int MI>
DEV void acc_zero(f32x16 (&acc)[NBM][MI][2]) {
#pragma unroll
  for (int nb = 0; nb < NBM; ++nb)
#pragma unroll
    for (int mi = 0; mi < MI; ++mi)
#pragma unroll
      for (int ni = 0; ni < 2; ++ni)
#pragma unroll
        for (int e = 0; e < 16; ++e) acc[nb][mi][ni][e] = 0.f;
}
#define ACC_ROW(mi, reg) (64 * wm + 32 * (mi) + ((reg) & 3) + 8 * ((reg) >> 2) + 4 * h)
#define ACC_COL(ni) (64 * wn + 32 * (ni) + r)
#define ACC_IDS                                                                                     \
  const int tid = opaque_tid(), lane = tid & 63, w = tid >> 6, wm = w >> 1, wn = w & 1, r = lane & 31, \
            h = lane >> 5;                                                                          \
  (void)tid; (void)lane; (void)w; (void)wm; (void)wn; (void)r; (void)h;

DEV void phase_mod(const P& p, char* smem) {
  float* sc = (float*)smem;
  float* red = sc + 17 * 256;
  const int tid = opaque_tid(), kg = tid >> 5, cn = tid & 31;
  float* MOD = (float*)(p.ws + OFF_MOD);
  for (int i = blockIdx.x * 256 + tid; i < 4 * 8448; i += gridDim.x * 256) ((int*)(p.ws + OFF_SCH))[i] = 0;
  for (int task = blockIdx.x; task < 384; task += gridDim.x) {
    const int l = task / 192, n0 = (task % 192) * 32;
    const float* W = p.in[4] + (size_t)l * 1024 * 6144;
    float acc[17];
#pragma unroll
    for (int i = 0; i < 17; ++i) acc[i] = 0.f;
    for (int s = 0; s < 4; ++s) {
      __syncthreads();
      for (int i = tid; i < 17 * 256; i += 256) {
        int rr = i >> 8, k = i & 255;
        float c = (rr < 16) ? p.in[1][rr * 1024 + s * 256 + k] : p.in[3][s * 256 + k];
        sc[i] = siluf_(c);
      }
      __syncthreads();
#pragma unroll 8
      for (int kk = 0; kk < 32; ++kk) {
        int k = kg * 32 + kk;
        float wv = W[(size_t)(s * 256 + k) * 6144 + n0 + cn];
#pragma unroll
        for (int rr = 0; rr < 17; ++rr) acc[rr] += sc[rr * 256 + k] * wv;
      }
    }
#pragma unroll
    for (int rr = 0; rr < 17; ++rr) red[(kg * 17 + rr) * 32 + cn] = acc[rr];
    __syncthreads();
    for (int i = tid; i < 17 * 32; i += 256) {
      int rr = i >> 5, c = i & 31;
      float v = 0.f;
#pragma unroll
      for (int g = 0; g < 8; ++g) v += red[(g * 17 + rr) * 32 + c];
      MOD[(size_t)(l * 17 + rr) * 6144 + n0 + c] = v + p.in[5][l * 6144 + n0 + c];
    }
    __syncthreads();
  }
  float* COS = (float*)(p.ws + OFF_COS);
  float* SIN = (float*)(p.ws + OFF_SIN);
  for (int i = blockIdx.x * 256 + tid; i < 2048 * 32; i += gridDim.x * 256) {
    int n = i >> 5, j = i & 31;
    int rowi = n >> 6, coli = n & 63;
    float inv = powf(10000.f, -(float)(j & 15) / 16.f);
    float ang = (float)(j < 16 ? rowi : coli) * inv;
    COS[i] = cosf(ang);
    SIN[i] = sinf(ang);
  }
  conv_batch(p.in[6], (bf16_t*)(p.ws + OFF_WINT), 1024, 3968, 1, (float*)smem, tid);
  conv_batch(p.in[9], (bf16_t*)(p.ws + OFF_LW), 64, 256, 4, (float*)smem, tid);
  conv_batch(p.in[11], (bf16_t*)(p.ws + OFF_LW) + 65536, 64, 256, 4, (float*)smem, tid);
  conv_batch(p.in[12], (bf16_t*)(p.ws + OFF_LW) + 131072, 128, 256, 2, (float*)smem, tid);
}

DEV bool tile_map(int it, int R, int C, int& rt, int& ct) {
  const int x = blockIdx.x & 7, j = blockIdx.x >> 3, nb8 = gridDim.x >> 3;
  const int q = it * nb8 + j;
  const int s = (q >> 6) * 8 + x, w = q & 63;
  const int c8 = C >> 3;
  if (s >= (R >> 3) * c8) return false;
  const int sr = s / c8, sc = s - sr * c8;
  rt = sr * 8 + (w >> 3);
  ct = sc * 8 + (w & 7);
  return true;
}

DEV void store_rowpair_bf16(bf16_t* base, size_t ld, int R, int c, float ve, float ve1) {
  const bool odd = (c & 1) != 0;
  const float snd = odd ? ve : ve1;
  const float rcv = __int_as_float(__builtin_amdgcn_update_dpp(0, __float_as_int(snd), 0xB1, 0xF, 0xF, true));
  const unsigned pk = odd ? pack2(rcv, ve1) : pack2(ve, rcv);
  *(unsigned*)(base + (size_t)(odd ? R + 1 : R) * ld + (odd ? c - 1 : c)) = pk;
}

DEV void write_u_row(const P& p, int lnext, int row, const float4& x, int n) {
  const float* mr = mod_row(p, lnext, row);
  float4 sh = *(const float4*)(mr + n), sc = *(const float4*)(mr + 1024 + n);
  uint2 o;
  o.x = pack2(x.x * (1.f + sc.x) + sh.x, x.y * (1.f + sc.y) + sh.y);
  o.y = pack2(x.z * (1.f + sc.z) + sh.z, x.w * (1.f + sc.w) + sh.w);
  *(uint2*)((bf16_t*)(p.ws + OFF_U) + (size_t)row * D_ + n) = o;
}
DEV void phase_u(const P& p, char* smem) {
  const int tid = opaque_tid(), n = tid * 4;
  for (int row = blockIdx.x; row < ROWS_; row += gridDim.x) {
    float4 x = *(const float4*)(xin_row(p, 0, row) + n);
    write_u_row(p, 0, row, x, n);
  }
}

DEV void phase_in(const P& p, int l, char* smem) {
  GemmSmem* sm = (GemmSmem*)smem;
  ACC_IDS
  const bf16_t* WT = (const bf16_t*)(p.ws + (l == 0 ? OFF_WINT : OFF_WINT1));
  int mt, np;
  for (int it = 0; tile_map(it, 288, 16, mt, np); ++it) {
    ALBf al;
#pragma unroll
    for (int i = 0; i < 2; ++i) al.ap[i] = (const bf16_t*)(p.ws + OFF_U) + (size_t)(mt * 128 + (tid >> 2) + 64 * i) * D_;
    f32x16 acc[2][2][2];
    acc_zero<2, 2>(acc);
    const bf16_t* B0 = WT + (size_t)(np * 256) * 1024;
    const bf16_t* B1 = (np < 15) ? B0 + (size_t)128 * 1024 : B0;
    gemm_core<2, 2>(al, B0, B1, 1024, 1024, sm, acc, tid);
#pragma unroll
    for (int nb = 0; nb < 2; ++nb) {
      const int nt = 2 * np + nb;
      if (nt < 31) {
        bf16_t* Z;
        int ld, c0;
        if (nt < 9) { Z = (bf16_t*)(p.ws + OFF_ZA); ld = 1152; c0 = nt * 128; }
        else if (nt < 17) { Z = (bf16_t*)(p.ws + OFF_ZB); ld = 1024; c0 = (nt - 9) * 128; }
        else if (nt < 27) { Z = (bf16_t*)(p.ws + OFF_ZC); ld = 1280; c0 = (nt - 17) * 128; }
        else { Z = (bf16_t*)(p.ws + OFF_ZD); ld = 512; c0 = (nt - 27) * 128; }
#pragma unroll
        for (int mi = 0; mi < 2; ++mi)
#pragma unroll
          for (int ni = 0; ni < 2; ++ni)
#pragma unroll
            for (int e = 0; e < 16; e += 2)
              store_rowpair_bf16(Z, ld, mt * 128 + ACC_ROW(mi, e), c0 + ACC_COL(ni), acc[nb][mi][ni][e], acc[nb][mi][ni][e + 1]);
      }
    }
  }
}

DEV float za_mix(const bf16_t* ZA, const float* mu, int b, int t, int col) {
  const bf16_t* z = ZA + ((size_t)b * T_ + t) * 1152 + col;
  float zc = bf2f(z[0]);
  bool hasl = (t != 0 && t != NC_), hasr = (t != NC_ - 1 && t != T_ - 1);
  float zl = hasl ? bf2f(z[-1152]) : 0.f;
  float zr = hasr ? bf2f(z[1152]) : 0.f;
  return zc + mu[col] * (0.5f * (zl + zr) - zc);
}

DEV void za_mix8(const bf16_t* ZA, const float (&mu)[8], int b, int t, int col, float (&o)[8]) {
  const bf16_t* z = ZA + ((size_t)b * T_ + t) * 1152 + col;
  const bool hasl = (t != 0 && t != NC_), hasr = (t != NC_ - 1 && t != T_ - 1);
  const uint4 zero4 = make_uint4(0, 0, 0, 0);
  uint4 uc = *(const uint4*)z;
  uint4 ul = hasl ? *(const uint4*)(z - 1152) : zero4;
  uint4 ur = hasr ? *(const uint4*)(z + 1152) : zero4;
  float c[8], lft[8], rgt[8];
  unpack8(uc, c); unpack8(ul, lft); unpack8(ur, rgt);
#pragma unroll
  for (int j = 0; j < 8; ++j) o[j] = c[j] + mu[j] * (0.5f * (lft[j] + rgt[j]) - c[j]);
}

DEV void phase_prep(const P& p, int l, char* smem) {
  const int tid = opaque_tid(), lane = tid & 63, wv = tid >> 6;
  const bf16_t* ZA = (const bf16_t*)(p.ws + OFF_ZA);
  const bf16_t* ZD = (const bf16_t*)(p.ws + OFF_ZD);
  const float* mu = p.in[7] + l * 1152;
  bf16_t* RWR = (bf16_t*)(p.ws + OFF_RWR);
  bf16_t* RWK = RWR + RWSZ;
  bf16_t* RWV = RWK + RWSZ;
  bf16_t* RWKK = RWV + RWSZ;
  bf16_t* RWBG = (bf16_t*)(p.ws + OFF_RWG) + RWSZ;
  bf16_t* LI = (bf16_t*)((char*)p.out + OUT_Y1);
  bf16_t* ATQ = (bf16_t*)((char*)p.out + OUT_ATQ);
  bf16_t* ATK = (bf16_t*)((char*)p.out + OUT_ATK);
  const float* COS = (const float*)(p.ws + OFF_COS);
  const float* SIN = (const float*)(p.ws + OFF_SIN);
  const int gw = blockIdx.x * 4 + wv, nw = gridDim.x * 4;
  {
    const int c8 = (lane & 31) * 8;
    float mur[8], muk[8], muv[8], kkw[8], rkw[8];
    ld8f(mu + c8, mur); ld8f(mu + 256 + c8, muk); ld8f(mu + 512 + c8, muv);
    ld8f(p.in[13] + l * 256 + c8, kkw); ld8f(p.in[15] + l * 256 + c8, rkw);
    for (int pr = gw; pr < ROWS_ / 2; pr += nw) {
      const int row = 2 * pr + (lane >> 5);
      const int b = row / T_, t = row - b * T_;
      float rv[8], kv[8], vv[8];
      za_mix8(ZA, mur, b, t, c8, rv);
      za_mix8(ZA, muk, b, t, 256 + c8, kv);
      za_mix8(ZA, muv, b, t, 512 + c8, vv);
      float kkf[8], ss = 0.f, rk = 0.f;
#pragma unroll
      for (int j = 0; j < 8; ++j) { kkf[j] = kv[j] * kkw[j]; ss += kkf[j] * kkf[j]; rk += rv[j] * kv[j] * rkw[j]; }
      ss = reduce8(ss);
      rk = reduce8(rk);
      const float rn = rsqrtf(ss + 1e-12f);
      float bon[8];
#pragma unroll
      for (int j = 0; j < 8; ++j) { kkf[j] *= rn; bon[j] = rk * vv[j]; }
      const size_t o = (size_t)row * 256 + c8;
      *(uint4*)(RWR + o) = pack8(rv);
      *(uint4*)(RWK + o) = pack8(kv);
      *(uint4*)(RWV + o) = pack8(vv);
      *(uint4*)(RWKK + o) = pack8(kkf);
      *(uint4*)(RWBG + o) = pack8(bon);
#pragma unroll
      for (int ps = 0; ps < 2; ++ps) {
        const int id = lane + 64 * ps;
        if (id < 96) {
          const int rs = id / 48, ck = id - rs * 48;
          const int row2 = 2 * pr + rs;
          const int b2 = row2 / T_, t2 = row2 - b2 * T_;
          float mul[8], lv[8];
          ld8f(mu + 768 + ck * 8, mul);
          za_mix8(ZA, mul, b2, t2, 768 + ck * 8, lv);
          if (ck < 16) {
#pragma unroll
            for (int j = 0; j < 8; ++j) lv[j] = tanhf(lv[j]);
          } else if (ck >= 32) {
#pragma unroll
            for (int j = 0; j < 8; ++j) lv[j] = sigmoidf_(lv[j]);
          }
          *(uint4*)(LI + (size_t)row2 * 384 + ck * 8) = pack8(lv);
        }
      }
    }
  }
  {
    const int hc = lane & 7;
    const bool isq = lane < 32, act = lane < 48;
    float gown[8], gpar[8];
    const float* gsrc = (isq ? p.in[23] : p.in[24]) + l * 64;
    ld8f(gsrc + hc * 8, gown);
    ld8f(gsrc + (hc ^ 4) * 8, gpar);
    for (int row = gw; row < ROWS_; row += nw) {
      const int t = row % T_;
      if (act) {
        const bf16_t* z = ZD + (size_t)row * 512;
        float xo[8], xp[8];
        unpack8(*(const uint4*)(z + lane * 8), xo);
        unpack8(*(const uint4*)(z + (lane ^ 4) * 8), xp);
        float ss = 0.f;
#pragma unroll
        for (int j = 0; j < 8; ++j) ss += xo[j] * xo[j];
        ss = reduce8(ss);
        const float rn = rsqrtf(ss * (1.f / 64.f) + 1e-6f);
        float cs[8], sn[8];
        if (t >= NC_) {
          ld8f(COS + (t - NC_) * 32 + (hc & 3) * 8, cs);
          ld8f(SIN + (t - NC_) * 32 + (hc & 3) * 8, sn);
        } else {
#pragma unroll
          for (int j = 0; j < 8; ++j) { cs[j] = 1.f; sn[j] = 0.f; }
        }
        float o[8];
        const float scl = isq ? 0.125f : 1.f;
#pragma unroll
        for (int j = 0; j < 8; ++j) {
          const float a = xo[j] * rn * gown[j], bq = xp[j] * rn * gpar[j];
          o[j] = ((hc & 4) == 0 ? (a * cs[j] - bq * sn[j]) : (bq * sn[j] + a * cs[j])) * scl;
        }
        if (isq) *(uint4*)(ATQ + (size_t)row * 256 + lane * 8) = pack8(o);
        else *(uint4*)(ATK + (size_t)row * 128 + (lane - 32) * 8) = pack8(o);
      }
    }
  }
}

DEV void phase_prep2(const P& p, int l, char* smem) {
  GemmSmem* sm = (GemmSmem*)smem;
  ACC_IDS
  const bf16_t* LI = (const bf16_t*)((const char*)p.out + OUT_Y1);
  const bf16_t* LW = (const bf16_t*)(p.ws + OFF_LW);
  float* RWW = (float*)(p.ws + OFF_RWW);
  bf16_t* RWA = (bf16_t*)(p.ws + OFF_RWA);
  bf16_t* RWG = (bf16_t*)(p.ws + OFF_RWG);
  bf16_t* RWBG = RWG + RWSZ;
  for (int tile = blockIdx.x; tile < 288 * 10; tile += gridDim.x) {
    const int mt = tile / 10, nt = tile % 10;
    const int kind = nt >> 1, chalf = nt & 1;
    const int K = (kind == 4) ? 128 : 64;
    const int koff = (kind == 4) ? 256 : kind * 64;
    const bf16_t* Bt;
    if (kind < 2) Bt = LW + (size_t)((l * 2 + kind) * 256) * 64;
    else if (kind < 4) Bt = LW + 65536 + (size_t)((l * 2 + (kind - 2)) * 256) * 64;
    else Bt = LW + 131072 + (size_t)(l * 256) * 128;
    Bt += (size_t)(chalf * 128) * K;
    ALBf al;
#pragma unroll
    for (int i = 0; i < 2; ++i) al.ap[i] = LI + (size_t)(mt * 128 + (tid >> 2) + 64 * i) * 384 + koff;
    f32x16 acc[1][2][2];
    acc_zero<1, 2>(acc);
    gemm_core<1, 2>(al, Bt, nullptr, K, K, sm, acc, tid);
    const int d = kind & 1;
#pragma unroll
    for (int ni = 0; ni < 2; ++ni) {
      const int ch = chalf * 128 + ACC_COL(ni);
      const float c0 = (kind < 2) ? p.in[8][(l * 2 + d) * 256 + ch] : ((kind < 4) ? p.in[10][(l * 2 + d) * 256 + ch] : 0.f);
#pragma unroll
      for (int mi = 0; mi < 2; ++mi)
#pragma unroll
        for (int e = 0; e < 16; e += 2) {
          const int R = mt * 128 + ACC_ROW(mi, e);
          const size_t o = (size_t)R * 256 + ch;
          const float v0 = acc[0][mi][ni][e], v1 = acc[0][mi][ni][e + 1];
          if (kind < 2) {
            float x0 = -(c0 + v0), x1 = -(c0 + v1);
            float sp0 = fmaxf(x0, 0.f) + log1pf(__expf(-fabsf(x0))), sp1 = fmaxf(x1, 0.f) + log1pf(__expf(-fabsf(x1)));
            RWW[(size_t)d * RWSZ + o] = __expf(-__expf(-sp0 - 0.5f));
            RWW[(size_t)d * RWSZ + o + 256] = __expf(-__expf(-sp1 - 0.5f));
          } else if (kind < 4) {
            store_rowpair_bf16(RWA + (size_t)d * RWSZ, 256, R, ch, sigmoidf_(c0 + v0), sigmoidf_(c0 + v1));
          } else {
            const float b0 = bf2f(RWBG[o]), b1 = bf2f(RWBG[o + 256]);
            store_rowpair_bf16(RWG, 256, R, ch, v0, v1);
            store_rowpair_bf16(RWBG, 256, R, ch, b0 * v0, b1 * v1);
          }
        }
    }
  }
}

DEV int scan_tok(int d, int j) { return d == 0 ? j : (j < NC_ ? NC_ - 1 - j : (T_ + NC_ - 1) - j); }

DEV float quad_sum(float v) {
  v += __int_as_float(__builtin_amdgcn_update_dpp(0, __float_as_int(v), 0xB1, 0xF, 0xF, true));
  v += __int_as_float(__builtin_amdgcn_update_dpp(0, __float_as_int(v), 0x4E, 0xF, 0xF, true));
  return v;
}

constexpr int SCH = 16;
constexpr int SCHF = SCH * 384;
template <int MIX, int LPR>
DEV void scan_block(const P& p, int l, int task0, float* LB, const int tid) {
  constexpr int NF = 16 / LPR;
  const int lane = tid & 63, wv = tid >> 6;
  const int task = (LPR == 8) ? (task0 >> 1) : task0;
  const int rowbase = (LPR == 8) ? 32 * (task0 & 1) : 0;
  const int d = task & 1, hh = (task >> 1) & 3, b = task >> 3;
  const int c = hh * 64 + lane;
  const int col = rowbase + (64 / LPR) * wv + (lane / LPR), q = lane & (LPR - 1);
  f2_t S2[2 * NF];
#pragma unroll
  for (int i = 0; i < 2 * NF; ++i) S2[i] = (f2_t){0.f, 0.f};
  const float* RWW = (const float*)(p.ws + OFF_RWW) + (size_t)d * RWSZ;
  const bf16_t* RWA = (const bf16_t*)(p.ws + OFF_RWA) + (size_t)d * RWSZ;
  const bf16_t* RWR = (const bf16_t*)(p.ws + OFF_RWR);
  const bf16_t* RWK = RWR + RWSZ;
  const bf16_t* RWV = RWK + RWSZ;
  const bf16_t* RWKK = RWV + RWSZ;
  const bf16_t* ZB = (const bf16_t*)(p.ws + OFF_ZB);
  const bf16_t* ZC = (const bf16_t*)(p.ws + OFF_ZC);
  const float* COS = (const float*)(p.ws + OFF_COS);
  const float* SIN = (const float*)(p.ws + OFF_SIN);
  bf16_t* Y = (MIX == 0) ? (bf16_t*)(p.ws + OFF_Y0)
                         : (MIX == 1 ? (bf16_t*)((char*)p.out + OUT_Y1) : (bf16_t*)((char*)p.out + OUT_Y2));
  Y += (size_t)d * RWSZ;
  float cst0 = 0.f, cst1 = 0.f;
  if (MIX == 0) cst0 = p.in[14][l * 256 + c];
  if (MIX == 1) cst0 = sigmoidf_(p.in[18][(l * 2 + d) * 4 + hh]);
  if (MIX == 2) {
    float h0 = p.in[21][(d * 2 + 0) * 256 + c], h1 = p.in[21][(d * 2 + 1) * 256 + c];
    cst0 = (l == 0) ? 0.f : sigmoidf_(h1 - h0);
    cst1 = 1.f - cst0;
  }
  constexpr int NV = (MIX == 0) ? 6 : (MIX == 1 ? 7 : 3);
  constexpr int SPW = SCH / 4;
  float pf[SPW][NV];
  auto issue = [&](int j0) __attribute__((always_inline)) {
#pragma unroll
    for (int s2 = 0; s2 < SPW; ++s2) {
      const int t = scan_tok(d, j0 + SPW * wv + s2);
      const size_t row = (size_t)b * T_ + t;
      if (MIX == 0) {
        pf[s2][0] = RWW[row * 256 + c];
        pf[s2][1] = bf2f(RWA[row * 256 + c]);
        pf[s2][2] = bf2f(RWR[row * 256 + c]);
        pf[s2][3] = bf2f(RWK[row * 256 + c]);
        pf[s2][4] = bf2f(RWKK[row * 256 + c]);
        pf[s2][5] = bf2f(RWV[row * 256 + c]);
      } else if (MIX == 1) {
        const bf16_t* z = ZB + row * 1024;
        pf[s2][0] = bf2f(z[c]);
        pf[s2][1] = bf2f(z[c ^ 32]);
        pf[s2][2] = bf2f(z[256 + c]);
        pf[s2][3] = bf2f(z[256 + (c ^ 32)]);
        pf[s2][4] = bf2f(z[512 + c]);
        if (t >= NC_) {
          pf[s2][5] = COS[(t - NC_) * 32 + (lane & 31)];
          pf[s2][6] = SIN[(t - NC_) * 32 + (lane & 31)];
        } else {
          pf[s2][5] = 1.f;
          pf[s2][6] = 0.f;
        }
      } else {
        const bf16_t* z = ZC + row * 1280;
        pf[s2][0] = bf2f(z[c]);
        pf[s2][1] = bf2f(z[256 + d * 256 + c]);
        pf[s2][2] = bf2f(z[768 + c]);
      }
    }
  };
  auto commit = [&](float* Lb) __attribute__((always_inline)) {
#pragma unroll
    for (int s2 = 0; s2 < SPW; ++s2) {
      float* Ls = Lb + (SPW * wv + s2) * 384;
      if (MIX == 0) {
        float wd = pf[s2][0], a = pf[s2][1], rv = pf[s2][2], kv = pf[s2][3], kk = pf[s2][4], vv = pf[s2][5];
        Ls[lane] = wd;
        Ls[64 + lane] = kk;
        Ls[128 + lane] = kk * a;
        Ls[192 + lane] = kv * (1.f + (a - 1.f) * cst0);
        Ls[256 + lane] = rv;
        Ls[320 + lane] = vv;
      } else if (MIX == 1) {
        float cs = pf[s2][5], sn = pf[s2][6];
        float qq = (lane < 32) ? (pf[s2][0] * cs - pf[s2][1] * sn) : (pf[s2][1] * sn + pf[s2][0] * cs);
        float kk = (lane < 32) ? (pf[s2][2] * cs - pf[s2][3] * sn) : (pf[s2][3] * sn + pf[s2][2] * cs);
        Ls[lane] = qq;
        Ls[64 + lane] = kk * 0.125f;
        Ls[128 + lane] = pf[s2][4];
      } else {
        float x = pf[s2][1];
        float sg = 1.f / (1.f + __expf(-x));
        Ls[lane] = cst0 + cst1 * sg;
        Ls[128 + lane] = siluf_(pf[s2][0]);
        Ls[192 + lane] = pf[s2][2];
      }
    }
  };
  __syncthreads();
  issue(0);
  commit(LB);
  __syncthreads();
  for (int j0 = 0; j0 < T_; j0 += SCH) {
    const int cb = (j0 / SCH) & 1;
    const float* Lc = LB + cb * SCHF;
    float* Ln = LB + (cb ^ 1) * SCHF;
    if (j0 + SCH < T_) issue(j0 + SCH);
    {
      constexpr int NX = ((MIX == 0) ? 4 : 2) * NF;
      f4v XA[NX], XB[NX], KA[NF], KB[NF];
      float vvA, vvB;
      auto ldk = [&](const float* Ls, f4v (&dst)[NF]) __attribute__((always_inline)) {
        const f4v* L4 = (const f4v*)Ls;
#pragma unroll
        for (int i = 0; i < NF; ++i) dst[i] = L4[16 + NF * q + i];
      };
      auto ldx = [&](const float* Ls, f4v (&X)[NX], float& vv) __attribute__((always_inline)) {
        const f4v* L4 = (const f4v*)Ls;
        if (MIX == 0) {
#pragma unroll
          for (int i = 0; i < NF; ++i) {
            X[i] = L4[NF * q + i];
            X[NF + i] = L4[32 + NF * q + i];
            X[2 * NF + i] = L4[48 + NF * q + i];
            X[3 * NF + i] = L4[64 + NF * q + i];
          }
          vv = Ls[320 + col];
        } else if (MIX == 1) {
#pragma unroll
          for (int i = 0; i < NF; ++i) {
            X[i] = L4[NF * q + i];
            X[NF + i] = L4[16 + NF * q + i];
          }
          vv = Ls[128 + col];
        } else {
#pragma unroll
          for (int i = 0; i < NF; ++i) {
            X[i] = L4[NF * q + i];
            X[NF + i] = L4[32 + NF * q + i];
          }
          vv = Ls[192 + col];
        }
      };
      auto lsum = [&](float v) __attribute__((always_inline)) -> float { return (LPR == 8) ? reduce8(v) : quad_sum(v); };
      auto step = [&](const f4v (&kq)[NF], const f4v (&X)[NX], const float vv) __attribute__((always_inline)) -> float {
        f2_t o2a = {0.f, 0.f}, o2b = {0.f, 0.f};
        if (MIX == 0) {
          f2_t a2 = {0.f, 0.f}, b2 = {0.f, 0.f};
#pragma unroll
          for (int i = 0; i < NF; ++i) {
            a2 += S2[2 * i] * kq[i].lo;
            b2 += S2[2 * i + 1] * kq[i].hi;
          }
          a2 += b2;
          const float nskk = -lsum(a2.x + a2.y);
          const f2_t ns2 = {nskk, nskk}, vv2 = {vv, vv};
#pragma unroll
          for (int i = 0; i < NF; ++i) {
            f2_t s0 = S2[2 * i] * X[i].lo + ns2 * X[NF + i].lo + vv2 * X[2 * NF + i].lo;
            f2_t s1 = S2[2 * i + 1] * X[i].hi + ns2 * X[NF + i].hi + vv2 * X[2 * NF + i].hi;
            S2[2 * i] = s0;
            S2[2 * i + 1] = s1;
            o2a += s0 * X[3 * NF + i].lo;
            o2b += s1 * X[3 * NF + i].hi;
          }
        } else if (MIX == 1) {
          const f2_t gm2 = {cst0, cst0}, vv2 = {vv, vv};
#pragma unroll
          for (int i = 0; i < NF; ++i) {
            f2_t s0 = S2[2 * i] * gm2 + X[NF + i].lo * vv2;
            f2_t s1 = S2[2 * i + 1] * gm2 + X[NF + i].hi * vv2;
            S2[2 * i] = s0;
            S2[2 * i + 1] = s1;
            o2a += s0 * X[i].lo;
            o2b += s1 * X[i].hi;
          }
        } else {
          const f2_t vv2 = {vv, vv};
#pragma unroll
          for (int i = 0; i < NF; ++i) {
            f2_t s0 = (S2[2 * i] - vv2) * X[i].lo + vv2;
            f2_t s1 = (S2[2 * i + 1] - vv2) * X[i].hi + vv2;
            S2[2 * i] = s0;
            S2[2 * i + 1] = s1;
            o2a += s0 * X[NF + i].lo;
            o2b += s1 * X[NF + i].hi;
          }
        }
        o2a += o2b;
        return lsum(o2a.x + o2a.y);
      };
      if (MIX == 0) ldk(Lc, KA);
      else ldx(Lc, XA, vvA);
      float keep = 0.f;
#pragma unroll
      for (int s = 0; s < SCH; ++s) {
        float o;
        if (MIX == 0) {
          ldx(Lc + s * 384, XA, vvA);
          if ((s & 1) == 0) {
            if (s + 1 < SCH) ldk(Lc + (s + 1) * 384, KB);
            __builtin_amdgcn_sched_barrier(0);
            o = step(KA, XA, vvA);
          } else {
            if (s + 1 < SCH) ldk(Lc + (s + 1) * 384, KA);
            __builtin_amdgcn_sched_barrier(0);
            o = step(KB, XA, vvA);
          }
        } else {
          if ((s & 1) == 0) {
            if (s + 1 < SCH) ldx(Lc + (s + 1) * 384, XB, vvB);
            __builtin_amdgcn_sched_barrier(0);
            o = step(KA, XA, vvA);
          } else {
            if (s + 1 < SCH) ldx(Lc + (s + 1) * 384, XA, vvA);
            __builtin_amdgcn_sched_barrier(0);
            o = step(KA, XB, vvB);
          }
        }
        keep = ((s & (LPR - 1)) == q) ? o : keep;
        if ((s & (LPR - 1)) == LPR - 1) {
          const int t = scan_tok(d, j0 + (s & ~(LPR - 1)) + q);
          Y[((size_t)b * T_ + t) * 256 + hh * 64 + col] = f2bf(keep);
        }
      }
    }
    if (j0 + SCH < T_) commit(Ln);
    __syncthreads();
  }
}

struct AttSmem {
  bf16_t k[64 * 72];
  bf16_t vt[64 * 72];
};

DEV void attn_task(const P& p, int l, int task, AttSmem* sm, const int tid) {
  const int lane = tid & 63, w = tid >> 6, r = lane & 31, h = lane >> 5;
  int b, hq, q0, nkeys;
  if (task < 1024) { b = task >> 6; hq = (task >> 4) & 3; q0 = NC_ + (task & 15) * 128; nkeys = T_; }
  else { int t2 = task - 1024; b = t2 >> 3; hq = (t2 >> 1) & 3; q0 = (t2 & 1) * 128; nkeys = NC_; }
  const int kvh = hq >> 1;
  const bf16_t* ATQ = (const bf16_t*)((const char*)p.out + OUT_ATQ);
  const bf16_t* ATK = (const bf16_t*)((const char*)p.out + OUT_ATK);
  bf16_t* ATO = (bf16_t*)((char*)p.out + OUT_ATO);
  const bf16_t* ZD = (const bf16_t*)(p.ws + OFF_ZD);
  const size_t qrow = (size_t)b * T_ + q0 + 32 * w + r;
  bf16x8 qf[4];
#pragma unroll
  for (int ks = 0; ks < 4; ++ks) qf[ks] = *(const bf16x8*)(ATQ + qrow * 256 + hq * 64 + 16 * ks + 8 * h);
  f32x16 O[2];
#pragma unroll
  for (int e = 0; e < 16; ++e) { O[0][e] = 0.f; O[1][e] = 0.f; }
  float m = -1e30f, lsum = 0.f;
  u4v kreg0, kreg1, vreg0, vreg1;
  auto kv_issue = [&](int kt) __attribute__((always_inline)) {
    const int q0 = tid, q1 = tid + 256;
    kreg0 = *(const u4v*)(ATK + ((size_t)b * T_ + kt + (q0 >> 3)) * 128 + kvh * 64 + 8 * (q0 & 7));
    kreg1 = *(const u4v*)(ATK + ((size_t)b * T_ + kt + (q1 >> 3)) * 128 + kvh * 64 + 8 * (q1 & 7));
    vreg0 = *(const u4v*)(ZD + ((size_t)b * T_ + kt + (q0 & 63)) * 512 + 384 + kvh * 64 + 8 * (q0 >> 6));
    vreg1 = *(const u4v*)(ZD + ((size_t)b * T_ + kt + (q1 & 63)) * 512 + 384 + kvh * 64 + 8 * (q1 >> 6));
  };
  auto v_scatter = [&](const u4v& vv, int q) __attribute__((always_inline)) {
    const int vkey = q & 63, vdc = q >> 6;
    bf16_t* dst = &sm->vt[(8 * vdc) * 72 + vkey];
    dst[0 * 72] = (bf16_t)(vv.x & 0xFFFFu); dst[1 * 72] = (bf16_t)(vv.x >> 16);
    dst[2 * 72] = (bf16_t)(vv.y & 0xFFFFu); dst[3 * 72] = (bf16_t)(vv.y >> 16);
    dst[4 * 72] = (bf16_t)(vv.z & 0xFFFFu); dst[5 * 72] = (bf16_t)(vv.z >> 16);
    dst[6 * 72] = (bf16_t)(vv.w & 0xFFFFu); dst[7 * 72] = (bf16_t)(vv.w >> 16);
  };
  kv_issue(0);
  for (int kt = 0; kt < nkeys; kt += 64) {
    __syncthreads();
    {
      const int q0 = tid, q1 = tid + 256;
      *(u4v*)&sm->k[(q0 >> 3) * 72 + 8 * (q0 & 7)] = kreg0;
      *(u4v*)&sm->k[(q1 >> 3) * 72 + 8 * (q1 & 7)] = kreg1;
      v_scatter(vreg0, q0);
      v_scatter(vreg1, q1);
    }
    __syncthreads();
    if (kt + 64 < nkeys) kv_issue(kt + 64);
    f32x16 Sx[2];
#pragma unroll
    for (int kb = 0; kb < 2; ++kb) {
#pragma unroll
      for (int e = 0; e < 16; ++e) Sx[kb][e] = 0.f;
#pragma unroll
      for (int ks = 0; ks < 4; ++ks) {
        bf16x8 kf = *(const bf16x8*)&sm->k[(32 * kb + r) * 72 + 16 * ks + 8 * h];
        Sx[kb] = __builtin_amdgcn_mfma_f32_32x32x16_bf16(kf, qf[ks], Sx[kb], 0, 0, 0);
      }
    }
    float mx = -1e30f;
#pragma unroll
    for (int kb = 0; kb < 2; ++kb)
#pragma unroll
      for (int e = 0; e < 16; ++e) mx = fmaxf(mx, Sx[kb][e]);
    mx = fmaxf(mx, __shfl_xor(mx, 32, 64));
    const float mnew = fmaxf(m, mx);
    const float scale = __expf(m - mnew);
    m = mnew;
    float ps = 0.f;
#pragma unroll
    for (int kb = 0; kb < 2; ++kb)
#pragma unroll
      for (int e = 0; e < 16; ++e) {
        float pv = __expf(Sx[kb][e] - mnew);
        Sx[kb][e] = pv;
        ps += pv;
      }
    lsum = lsum * scale + ps;
#pragma unroll
    for (int e = 0; e < 16; ++e) { O[0][e] *= scale; O[1][e] *= scale; }
#pragma unroll
    for (int kb = 0; kb < 2; ++kb)
#pragma unroll
      for (int s = 0; s < 2; ++s) {
        bf16x8 pfrag;
#pragma unroll
        for (int j = 0; j < 8; ++j) pfrag[j] = (short)f2bf(Sx[kb][8 * s + j]);
#pragma unroll
        for (int dt = 0; dt < 2; ++dt) {
          const bf16_t* vp = &sm->vt[(32 * dt + r) * 72 + 32 * kb + 16 * s + 4 * h];
          uint2 lo = *(const uint2*)vp, hi = *(const uint2*)(vp + 8);
          bf16x8 vf;
          uint4 tmp; tmp.x = lo.x; tmp.y = lo.y; tmp.z = hi.x; tmp.w = hi.y;
          vf = *(bf16x8*)&tmp;
          O[dt] = __builtin_amdgcn_mfma_f32_32x32x16_bf16(vf, pfrag, O[dt], 0, 0, 0);
        }
      }
  }
  const float ltot = lsum + __shfl_xor(lsum, 32, 64);
  const float invl = 1.f / ltot;
#pragma unroll
  for (int dt = 0; dt < 2; ++dt)
#pragma unroll
    for (int g = 0; g < 4; ++g) {
      uint2 v;
      v.x = pack2(O[dt][4 * g] * invl, O[dt][4 * g + 1] * invl);
      v.y = pack2(O[dt][4 * g + 2] * invl, O[dt][4 * g + 3] * invl);
      *(uint2*)(ATO + qrow * 256 + hq * 64 + 32 * dt + 8 * g + 4 * h) = v;
    }
}

DEV unsigned cu_key() {
  unsigned hw = __builtin_amdgcn_s_getreg((31 << 11) | (0 << 6) | 4);
  unsigned xcc = __builtin_amdgcn_s_getreg((3 << 11) | (0 << 6) | 20) & 0xFu;
  unsigned cu = (hw >> 8) & 0xFu, sh = (hw >> 12) & 1u, se = (hw >> 13) & 7u;
  return (xcc << 8) | (se << 5) | (sh << 4) | cu;
}

DEV void phase_scan(const P& p, int l, char* smem, int rep) {
  const int tid = opaque_tid();
  int* sch = (int*)(p.ws + OFF_SCH) + (l + 2 * rep) * 8448;
  int* cu_cnt = sch;
  int* cu_rank = sch + 4096;
  int* misc = sch + 8192;
  int* sh = (int*)(smem + SMEM_BYTES - 16);
  __syncthreads();
  if (tid == 0) {
    const unsigned key = cu_key();
    const int slot = atomicAdd(&cu_cnt[key], 1);
    int rank;
    if (slot == 0) {
      rank = atomicAdd(&misc[0], 1);
      atomicExch(&cu_rank[key], rank + 1);
    } else {
      while ((rank = atomicAdd(&cu_rank[key], 0)) == 0) __builtin_amdgcn_s_sleep(2);
      rank -= 1;
    }
    sh[1] = (rank < 256) ? (slot == 0 ? 0 : 1) : 2;
  }
  __syncthreads();
  const int role = sh[1];
  const int nA = (l == 0) ? 1152 : 1024;
  for (int stage = 0; stage < 3; ++stage) {
    int qsel;
    if (role == 0) qsel = (stage == 0) ? 0 : (stage == 1 ? 1 : 2);
    else qsel = (stage == 0) ? 1 : (stage == 1 ? 2 : 0);
    const int qn = (qsel == 0) ? 256 : (qsel == 1 ? 256 : nA);
    for (;;) {
      __syncthreads();
      if (tid == 0) sh[0] = atomicAdd(&misc[1 + qsel], 1);
      __syncthreads();
      const int t = sh[0];
      if (t >= qn) break;
      if (qsel == 0) scan_block<0, 8>(p, l, t, (float*)smem, tid);
      else if (qsel == 1) {
        if (t < 128) scan_block<1, 4>(p, l, t, (float*)smem, tid);
        else scan_block<2, 4>(p, l, t - 128, (float*)smem, tid);
      } else attn_task(p, l, t, (AttSmem*)smem, tid);
    }
  }
}

DEV void phase_post(const P& p, int l, char* smem) {
  const int tid = opaque_tid();
  const bf16_t* Y0 = (const bf16_t*)(p.ws + OFF_Y0);
  const bf16_t* Y1 = (const bf16_t*)((const char*)p.out + OUT_Y1);
  const bf16_t* Y2 = (const bf16_t*)((const char*)p.out + OUT_Y2);
  const bf16_t* ATO = (const bf16_t*)((const char*)p.out + OUT_ATO);
  const bf16_t* ZB = (const bf16_t*)(p.ws + OFF_ZB);
  const bf16_t* ZC = (const bf16_t*)(p.ws + OFF_ZC);
  const bf16_t* RWG = (const bf16_t*)(p.ws + OFF_RWG);
  const bf16_t* RWBG = RWG + RWSZ;
  bf16_t* BR = (bf16_t*)(p.ws + OFF_BR);
  const int nm = n_mrows(l);
  {
    const int lane = tid & 63, wv = tid >> 6, c8 = (lane & 31) * 8;
    float ga[8], gb[8];
#pragma unroll
    for (int j = 0; j < 8; ++j) { ga[j] = 1.f; gb[j] = 0.f; }
    if (wv == 0) { ld8f(p.in[16] + l * 256 + c8, ga); ld8f(p.in[17] + l * 256 + c8, gb); }
    else if (wv == 1) { ld8f(p.in[19] + l * 256 + c8, ga); ld8f(p.in[20] + l * 256 + c8, gb); }
    else if (wv == 2) { ld8f(p.in[22] + l * 256 + c8, ga); }
    const bf16_t* Ysrc = (wv == 0) ? Y0 : (wv == 1 ? Y1 : Y2);
    for (int pr = blockIdx.x; pr < nm / 2; pr += gridDim.x) {
      const int mrow = 2 * pr + (lane >> 5);
      const size_t row = map_row(l, mrow);
      uint4 outv;
      if (wv == 3) {
        outv = *(const uint4*)(ATO + row * 256 + c8);
      } else {
        float y0[8], y1[8], y[8], o[8];
        unpack8(*(const uint4*)(Ysrc + row * 256 + c8), y0);
        unpack8(*(const uint4*)(Ysrc + RWSZ + row * 256 + c8), y1);
        float sm = 0.f, sq = 0.f;
#pragma unroll
        for (int j = 0; j < 8; ++j) { y[j] = y0[j] + y1[j]; sm += y[j]; sq += y[j] * y[j]; }
        if (wv == 2) {
          const float ms = reduce8(sq) * (1.f / 64.f);
          const float rn = rsqrtf(ms + 1e-6f);
          float g[8];
          unpack8(*(const uint4*)(ZC + row * 1280 + 1024 + c8), g);
#pragma unroll
          for (int j = 0; j < 8; ++j) o[j] = y[j] * rn * ga[j] * siluf_(g[j]);
        } else {
          const float mean = reduce8(sm) * (1.f / 64.f);
          float vs = 0.f;
#pragma unroll
          for (int j = 0; j < 8; ++j) { y[j] -= mean; vs += y[j] * y[j]; }
          const float var = reduce8(vs) * (1.f / 64.f);
          const float rn = rsqrtf(var + (wv == 0 ? 64e-5f : 1e-5f));
          if (wv == 0) {
            float g[8], bg[8];
            unpack8(*(const uint4*)(RWG + row * 256 + c8), g);
            unpack8(*(const uint4*)(RWBG + row * 256 + c8), bg);
#pragma unroll
            for (int j = 0; j < 8; ++j) o[j] = (y[j] * rn * ga[j] + gb[j]) * g[j] + bg[j];
          } else {
            float g[8];
            unpack8(*(const uint4*)(ZB + row * 1024 + 768 + c8), g);
#pragma unroll
            for (int j = 0; j < 8; ++j) o[j] = (y[j] * rn * ga[j] + gb[j]) * siluf_(g[j]);
          }
        }
        outv = pack8(o);
      }
      *(uint4*)(BR + (size_t)mrow * 1024 + wv * 256 + c8) = outv;
    }
  }
  {
    const int n = tid * 4;
#pragma unroll 2
    for (int mrow = blockIdx.x; mrow < nm; mrow += gridDim.x) {
      const int row = map_row(l, mrow);
      const float4 x = *(const float4*)(xin_row(p, l, row) + n);
      const float* mr = mod_row(p, l, row);
      const float4 sh = *(const float4*)(mr + n), sc = *(const float4*)(mr + 1024 + n);
      uint2 o;
      o.x = pack2(x.x * (1.f + sc.x) + sh.x, x.y * (1.f + sc.y) + sh.y);
      o.y = pack2(x.z * (1.f + sc.z) + sh.z, x.w * (1.f + sc.w) + sh.w);
      *(uint2*)(u2_row(p, row) + n) = o;
    }
  }
  conv_batch(p.in[25] + (size_t)l * 4 * 1024 * 1024, (bf16_t*)(p.ws + OFF_WGT), 1024, 1024, 4, (float*)smem, tid);
  conv_batch(p.in[26] + (size_t)l * 4 * 256 * 1024, (bf16_t*)(p.ws + OFF_WBT), 256, 1024, 4, (float*)smem, tid);
  conv_batch(p.in[27] + (size_t)l * 1024 * 1024, (bf16_t*)(p.ws + OFF_WOT), 1024, 1024, 1, (float*)smem, tid);
}

DEV void phase_merge(const P& p, int l, char* smem) {
  GemmSmem* sm = (GemmSmem*)smem;
  ACC_IDS
  {
    int* tc = (int*)(p.ws + OFF_TCNT);
    for (int i = blockIdx.x * 256 + tid; i < ROWS_; i += gridDim.x * 256) tc[i] = 0;
  }
  const bf16_t* BR = (const bf16_t*)(p.ws + OFF_BR);
  bf16_t* MRG = (bf16_t*)(p.ws + OFF_MRG);
  int mt, nt;
  unsigned* lds32 = (unsigned*)smem;
  for (int it = 0; tile_map(it, n_mrows(l) / 128, 8, mt, nt); ++it) {
    f32x16 mer[2][2];
#pragma unroll
    for (int mi = 0; mi < 2; ++mi)
#pragma unroll
      for (int ni = 0; ni < 2; ++ni)
#pragma unroll
        for (int e = 0; e < 16; ++e) mer[mi][ni][e] = 0.f;
    ALBf au, ab;
#pragma unroll
    for (int q = 0; q < 2; ++q) {
      const int mrow = mt * 128 + (tid >> 2) + 64 * q;
      au.ap[q] = u2_row(p, map_row(l, mrow));
      ab.ap[q] = BR + (size_t)mrow * 1024;
    }
    for (int i = 0; i < 4; ++i) {
      {
        f32x16 abr[1][2][2];
        acc_zero<1, 2>(abr);
        ALBf abi = ab;
        abi.ap[0] += i * 256;
        abi.ap[1] += i * 256;
        gemm_core<1, 2>(abi, (const bf16_t*)(p.ws + OFF_WBT) + ((size_t)(i * 1024 + nt * 128)) * 256, nullptr, 256, 256, sm, abr, tid);
#pragma unroll
        for (int mi = 0; mi < 2; ++mi)
#pragma unroll
          for (int ni = 0; ni < 2; ++ni)
#pragma unroll
            for (int e = 0; e < 8; ++e) {
              const int j = (mi * 2 + ni) * 8 + e;
              const int word = (j < 10) ? (7680 + j * 256) : (j < 20 ? (12800 + (j - 10) * 256) : (15360 + (j - 20) * 256));
              lds32[word + tid] = pack2(abr[0][mi][ni][2 * e], abr[0][mi][ni][2 * e + 1]);
            }
      }
      f32x16 ag[1][2][2];
      acc_zero<1, 2>(ag);
      gemm_core<1, 2>(au, (const bf16_t*)(p.ws + OFF_WGT) + ((size_t)(i * 1024 + nt * 128)) * 1024, nullptr, 1024, 1024, sm, ag, tid);
#pragma unroll
      for (int mi = 0; mi < 2; ++mi)
#pragma unroll
        for (int ni = 0; ni < 2; ++ni)
#pragma unroll
          for (int e = 0; e < 8; ++e) {
            const int j = (mi * 2 + ni) * 8 + e;
            const int word = (j < 10) ? (7680 + j * 256) : (j < 20 ? (12800 + (j - 10) * 256) : (15360 + (j - 20) * 256));
            const unsigned bp = lds32[word + tid];
            mer[mi][ni][2 * e] += sigmoidf_(ag[0][mi][ni][2 * e]) * __uint_as_float(bp << 16);
            mer[mi][ni][2 * e + 1] += sigmoidf_(ag[0][mi][ni][2 * e + 1]) * __uint_as_float(bp & 0xFFFF0000u);
          }
    }
#pragma unroll
    for (int mi = 0; mi < 2; ++mi)
#pragma unroll
      for (int ni = 0; ni < 2; ++ni)
#pragma unroll
        for (int e = 0; e < 16; e += 2)
          store_rowpair_bf16(MRG, 1024, mt * 128 + ACC_ROW(mi, e), nt * 128 + ACC_COL(ni), mer[mi][ni][e], mer[mi][ni][e + 1]);
  }
}

DEV void phase_out(const P& p, int l, char* smem) {
  GemmSmem* sm = (GemmSmem*)smem;
  ACC_IDS
  const bf16_t* MRG = (const bf16_t*)(p.ws + OFF_MRG);
  float* XA = (float*)(p.ws + OFF_XA);
  int mt, nt;
  for (int it = 0; tile_map(it, n_mrows(l) / 128, 8, mt, nt); ++it) {
    const bf16_t* apm[4];
#pragma unroll
    for (int q = 0; q < 4; ++q) apm[q] = MRG + (size_t)(mt * 128 + (tid >> 3) + 32 * q) * 1024;
    f32x16 acc[1][2][2];
    acc_zero<1, 2>(acc);
    gemm64<2>(apm, (const bf16_t*)(p.ws + OFF_WOT) + (size_t)(nt * 128) * 1024, 1024, 1024, (GemmSmem64*)smem, acc, tid);
#pragma unroll
    for (int mi = 0; mi < 2; ++mi)
#pragma unroll
      for (int e = 0; e < 16; ++e) {
        const int mrow = mt * 128 + ACC_ROW(mi, e);
        const int row = map_row(l, mrow);
        const float* xr = xin_row(p, l, row);
        const float* mr = mod_row(p, l, row);
#pragma unroll
        for (int ni = 0; ni < 2; ++ni) {
          int col = nt * 128 + ACC_COL(ni);
          XA[(size_t)row * D_ + col] = ALPHA * xr[col] + mr[2048 + col] * acc[0][mi][ni][e];
        }
      }
  }
}

DEV float block_sum(float v, float* red, const int tid) {
  v = wave_sum(v);
  __syncthreads();
  if ((tid & 63) == 0) red[tid >> 6] = v;
  __syncthreads();
  return (red[0] + red[1]) + (red[2] + red[3]);
}

DEV void phase_ln1(const P& p, int l, char* smem) {
  float* u2s = (float*)smem;
  float* part = u2s + 4096;
  const int tid = opaque_tid(), lane = tid & 63, wv = tid >> 6;
  float* XA = (float*)(p.ws + OFF_XA);
  float* AFF = (float*)(p.ws + OFF_AFF);
  const float* lng = p.in[28] + l * 1024;
  const float* lnb = p.in[29] + l * 1024;
  const int re = tid & 15, ng = tid >> 4;
  float wr[64];
  {
    const float* WR = p.in[30] + (size_t)l * 1024 * 16;
#pragma unroll
    for (int j = 0; j < 64; ++j) wr[j] = WR[(size_t)(ng * 64 + j) * 16 + re];
  }
  const int nm = n_mrows(l);
  for (int grp = blockIdx.x; grp < nm / 4; grp += gridDim.x) {
    const int mrow = grp * 4 + wv;
    const int row = map_row(l, mrow);
    const float* mr = mod_row(p, l, row);
    float4 v[4];
    float sm = 0.f;
#pragma unroll
    for (int i = 0; i < 4; ++i) {
      v[i] = *(const float4*)(XA + (size_t)row * D_ + 4 * lane + 256 * i);
      sm += (v[i].x + v[i].y) + (v[i].z + v[i].w);
    }
    const float mean = wave_sum(sm) * (1.f / 1024.f);
    float vs = 0.f;
#pragma unroll
    for (int i = 0; i < 4; ++i) {
      v[i].x -= mean; v[i].y -= mean; v[i].z -= mean; v[i].w -= mean;
      vs += (v[i].x * v[i].x + v[i].y * v[i].y) + (v[i].z * v[i].z + v[i].w * v[i].w);
    }
    const float rs = rsqrtf(wave_sum(vs) * (1.f / 1024.f) + 1e-5f);
#pragma unroll
    for (int i = 0; i < 4; ++i) {
      const int n = 4 * lane + 256 * i;
      const float4 gq = *(const float4*)(lng + n), bq = *(const float4*)(lnb + n);
      const float4 x1 = make_float4(v[i].x * rs * gq.x + bq.x, v[i].y * rs * gq.y + bq.y,
                                    v[i].z * rs * gq.z + bq.z, v[i].w * rs * gq.w + bq.w);
      *(float4*)(XA + (size_t)row * D_ + n) = x1;
      const float4 sh = *(const float4*)(mr + 3072 + n), scv = *(const float4*)(mr + 4096 + n);
      const float4 um = make_float4(x1.x * (1.f + scv.x) + sh.x, x1.y * (1.f + scv.y) + sh.y,
                                    x1.z * (1.f + scv.z) + sh.z, x1.w * (1.f + scv.w) + sh.w);
      *(float4*)(u2s + wv * 1024 + n) = um;
      uint2 ub;
      ub.x = pack2(um.x, um.y);
      ub.y = pack2(um.z, um.w);
      *(uint2*)((bf16_t*)(p.ws + OFF_XS) + (size_t)row * D_ + n) = ub;
    }
    __syncthreads();
    float acc[4] = {0.f, 0.f, 0.f, 0.f};
#pragma unroll
    for (int j4 = 0; j4 < 16; ++j4) {
#pragma unroll
      for (int rw = 0; rw < 4; ++rw) {
        const float4 u = *(const float4*)(u2s + rw * 1024 + ng * 64 + 4 * j4);
        acc[rw] += u.x * wr[4 * j4] + u.y * wr[4 * j4 + 1] + u.z * wr[4 * j4 + 2] + u.w * wr[4 * j4 + 3];
      }
    }
#pragma unroll
    for (int rw = 0; rw < 4; ++rw) part[(ng * 4 + rw) * 16 + re] = acc[rw];
    __syncthreads();
    if (tid < 64) {
      const int rw = tid >> 4;
      float lg = 0.f;
#pragma unroll
      for (int g = 0; g < 16; ++g) lg += part[(g * 4 + rw) * 16 + re];
      float mx = lg;
#pragma unroll
      for (int o = 8; o > 0; o >>= 1) mx = fmaxf(mx, __shfl_xor(mx, o, 16));
      const float ex = __expf(lg - mx);
      const float den = reduce16(ex);
      const int r2 = map_row(l, grp * 4 + rw);
      const int b = r2 / T_, t = r2 - b * T_;
      AFF[((size_t)(b * 16 + re)) * T_ + t] = ex / den;
    }
  }
  conv_batch(p.in[31] + (size_t)l * 16 * 1024 * 1024, (bf16_t*)(p.ws + OFF_WE1T), 1024, 1024, 16, (float*)smem, tid);
  conv_batch(p.in[32] + (size_t)l * 16 * 1024 * 1024, (bf16_t*)(p.ws + OFF_WE3T), 1024, 1024, 16, (float*)smem, tid);
  conv_batch(p.in[33] + (size_t)l * 16 * 1024 * 1024, (bf16_t*)(p.ws + OFF_WE2T), 1024, 1024, 16, (float*)smem, tid);
}

DEV void phase_topk(const P& p, int l, char* smem) {
  u64* keys = (u64*)smem;
  const int tid = opaque_tid();
  const float* AFF = (const float*)(p.ws + OFF_AFF);
  int* IDX = (int*)(p.ws + OFF_IDX);
  float* GATE = (float*)(p.ws + OFF_GATE);
  const int ntask = (l == 0) ? 512 : 256;
  for (int task = blockIdx.x; task < ntask; task += gridDim.x) {
    const int seg = task >> 8, be = task & 255;
    const int n = seg ? NC_ : NL_, t0 = seg ? 0 : NC_, cap = seg ? 32 : 256;
    const float* aff = AFF + (size_t)be * T_ + t0;
    __syncthreads();
    for (int i = tid; i < 2048; i += 256)
      keys[i] = (i < n) ? (((u64)__float_as_uint(aff[i]) << 32) | (u64)(0xFFFFFFFFu - (unsigned)i)) : 0ull;
    __syncthreads();
    for (int k = 2; k <= 2048; k <<= 1)
      for (int j = k >> 1; j > 0; j >>= 1) {
        for (int i = tid; i < 2048; i += 256) {
          int ixj = i ^ j;
          if (ixj > i) {
            u64 a = keys[i], bb = keys[ixj];
            bool desc = ((i & k) == 0);
            if (desc ? (a < bb) : (a > bb)) { keys[i] = bb; keys[ixj] = a; }
          }
        }
        const int nj = (j > 1) ? (j >> 1) : k;
        if (j == 64 || j == 128 || nj == 64 || nj == 128) __syncthreads();
        else {
          __builtin_amdgcn_fence(__ATOMIC_RELEASE, "wavefront");
          __builtin_amdgcn_wave_barrier();
          __builtin_amdgcn_fence(__ATOMIC_ACQUIRE, "wavefront");
        }
      }
    __syncthreads();
    for (int i = tid; i < cap; i += 256) {
      u64 kv = keys[i];
      IDX[be * 288 + seg * 256 + i] = (int)(0xFFFFFFFFu - (unsigned)(kv & 0xFFFFFFFFull));
      GATE[be * 288 + seg * 256 + i] = __uint_as_float((unsigned)(kv >> 32));
      {
        const int bb = be >> 4, ee = be & 15;
        const int tok = (int)(0xFFFFFFFFu - (unsigned)(kv & 0xFFFFFFFFull));
        const int grow = bb * T_ + t0 + tok;
        const int slot = seg ? (bb * 32 + i) : (bb * 256 + i);
        const int yrow = (ee * 36 + (seg ? 32 : 0) + (slot >> 7)) * 128 + (slot & 127);
        const int pos = atomicAdd((int*)(p.ws + OFF_TCNT) + grow, 1);
        uint2 ent;
        ent.x = (unsigned)yrow;
        ent.y = (unsigned)(kv >> 32);
        ((uint2*)(p.ws + OFF_TLIST))[(size_t)grow * 16 + (pos & 15)] = ent;
      }
    }
  }
}

DEV void slot_info(const P& p, int e, int mtile, int rr, int& row, float& gate, int& seg, int& b, int& idx) {
  const int* IDX = (const int*)(p.ws + OFF_IDX);
  const float* GATE = (const float*)(p.ws + OFF_GATE);
  if (mtile < 32) {
    int slot = mtile * 128 + rr;
    b = slot >> 8;
    int j = slot & 255;
    idx = IDX[(b * 16 + e) * 288 + j];
    gate = GATE[(b * 16 + e) * 288 + j];
    seg = 0;
    row = b * T_ + NC_ + idx;
  } else {
    int slot = (mtile - 32) * 128 + rr;
    b = slot >> 5;
    int j = slot & 31;
    idx = IDX[(b * 16 + e) * 288 + 256 + j];
    gate = GATE[(b * 16 + e) * 288 + 256 + j];
    seg = 1;
    row = b * T_ + idx;
  }
}

DEV void phase_eup(const P& p, int l, char* smem) {
  GemmSmem* sm = (GemmSmem*)smem;
  ACC_IDS
  const float* XA = (const float*)(p.ws + OFF_XA);
  bf16_t* H = (bf16_t*)(p.ws + OFF_H);
  const int MT = (l == 0) ? 36 : 32;
  int em, nt;
  for (int it = 0; tile_map(it, 16 * MT, 8, em, nt); ++it) {
    const int mt = em % MT, e = em / MT;
    ALBfIdx al;
    al.base = (const bf16_t*)(p.ws + OFF_XS);
#pragma unroll
    for (int q = 0; q < 2; ++q) {
      int row, seg, b, idx;
      float gate;
      slot_info(p, e, mt, (tid >> 2) + 64 * q, row, gate, seg, b, idx);
      al.off[q] = (unsigned)row * (unsigned)D_;
    }
    f32x16 acc[2][2][2];
    acc_zero<2, 2>(acc);
    const size_t wo = ((size_t)(e * 1024 + nt * 128)) * 1024;
    gemm_core<2, 2>(al, (const bf16_t*)(p.ws + OFF_WE1T) + wo, (const bf16_t*)(p.ws + OFF_WE3T) + wo, 1024, 1024, sm, acc, tid);
#pragma unroll
    for (int mi = 0; mi < 2; ++mi)
#pragma unroll
      for (int ni = 0; ni < 2; ++ni)
#pragma unroll
        for (int q = 0; q < 16; q += 2)
          store_rowpair_bf16(H, 1024, (e * 36 + mt) * 128 + ACC_ROW(mi, q), nt * 128 + ACC_COL(ni),
                             siluf_(acc[0][mi][ni][q]) * acc[1][mi][ni][q], siluf_(acc[0][mi][ni][q + 1]) * acc[1][mi][ni][q + 1]);
  }
}

DEV void phase_edown(const P& p, int l, char* smem) {
  ACC_IDS
  const bf16_t* H = (const bf16_t*)(p.ws + OFF_H);
  bf16_t* YE = (bf16_t*)(p.ws + OFF_YEXP);
  const int MT = (l == 0) ? 36 : 32;
  int em, nt;
  for (int it = 0; tile_map(it, 16 * MT, 8, em, nt); ++it) {
    const int mt = em % MT, e = em / MT;
    const bf16_t* aph[4];
#pragma unroll
    for (int q = 0; q < 4; ++q) aph[q] = H + (size_t)((e * 36 + mt) * 128 + (tid >> 3) + 32 * q) * 1024;
    f32x16 acc[1][2][2];
    acc_zero<1, 2>(acc);
    gemm64<2>(aph, (const bf16_t*)(p.ws + OFF_WE2T) + ((size_t)(e * 1024 + nt * 128)) * 1024, 1024, 1024, (GemmSmem64*)smem, acc, tid);
#pragma unroll
    for (int mi = 0; mi < 2; ++mi)
#pragma unroll
      for (int ni = 0; ni < 2; ++ni)
#pragma unroll
        for (int q = 0; q < 16; q += 2)
          store_rowpair_bf16(YE, 1024, (e * 36 + mt) * 128 + ACC_ROW(mi, q), nt * 128 + ACC_COL(ni), acc[0][mi][ni][q], acc[0][mi][ni][q + 1]);
  }
}

DEV void phase_ln2(const P& p, int l, char* smem) {
  const int tid = opaque_tid(), lane = tid & 63, wv = tid >> 6;
  float* XA = (float*)(p.ws + OFF_XA);
  const bf16_t* YE = (const bf16_t*)(p.ws + OFF_YEXP);
  const int* TC = (const int*)(p.ws + OFF_TCNT);
  const uint2* TL = (const uint2*)(p.ws + OFF_TLIST);
  float4 g4[4], b4[4];
#pragma unroll
  for (int i = 0; i < 4; ++i) {
    g4[i] = *(const float4*)(p.in[34] + l * 1024 + 4 * lane + 256 * i);
    b4[i] = *(const float4*)(p.in[35] + l * 1024 + 4 * lane + 256 * i);
  }
  const int nm = n_mrows(l);
  for (int mrow = blockIdx.x * 4 + wv; mrow < nm; mrow += gridDim.x * 4) {
    const int row = map_row(l, mrow);
    const int b = row / T_, t = row - b * T_;
    const float* mr = mod_row(p, l, row);
    float4 f[4];
#pragma unroll
    for (int i = 0; i < 4; ++i) f[i] = make_float4(0.f, 0.f, 0.f, 0.f);
    const int nc = min(TC[row], 16);
    uint2 ent4[4];
#pragma unroll
    for (int k = 0; k < 4; ++k) ent4[k] = TL[(size_t)row * 16 + k];
    auto add_contrib = [&](const uint2 ent) __attribute__((always_inline)) {
      const float gate = __uint_as_float(ent.y);
      const bf16_t* yr = YE + (size_t)ent.x * 1024;
#pragma unroll
      for (int i = 0; i < 4; ++i) {
        const uint2 yv = *(const uint2*)(yr + 4 * lane + 256 * i);
        f[i].x += gate * __uint_as_float(yv.x << 16);
        f[i].y += gate * __uint_as_float(yv.x & 0xFFFF0000u);
        f[i].z += gate * __uint_as_float(yv.y << 16);
        f[i].w += gate * __uint_as_float(yv.y & 0xFFFF0000u);
      }
    };
#pragma unroll
    for (int k = 0; k < 4; ++k)
      if (k < nc) add_contrib(ent4[k]);
    for (int k = 4; k < nc; ++k) add_contrib(TL[(size_t)row * 16 + k]);
    float4 v[4];
    float sm = 0.f;
#pragma unroll
    for (int i = 0; i < 4; ++i) {
      const int n = 4 * lane + 256 * i;
      const float4 x1 = *(const float4*)(XA + (size_t)row * D_ + n);
      const float4 g2 = *(const float4*)(mr + 5120 + n);
      v[i] = make_float4(ALPHA * x1.x + g2.x * f[i].x, ALPHA * x1.y + g2.y * f[i].y, ALPHA * x1.z + g2.z * f[i].z,
                         ALPHA * x1.w + g2.w * f[i].w);
      sm += (v[i].x + v[i].y) + (v[i].z + v[i].w);
    }
    const float mean = wave_sum(sm) * (1.f / 1024.f);
    float vs = 0.f;
#pragma unroll
    for (int i = 0; i < 4; ++i) {
      v[i].x -= mean; v[i].y -= mean; v[i].z -= mean; v[i].w -= mean;
      vs += (v[i].x * v[i].x + v[i].y * v[i].y) + (v[i].z * v[i].z + v[i].w * v[i].w);
    }
    const float rs = rsqrtf(wave_sum(vs) * (1.f / 1024.f) + 1e-5f);
    float* orow = p.out + ((size_t)(b * NL_ + t - NC_)) * D_;
#pragma unroll
    for (int i = 0; i < 4; ++i) {
      const int n = 4 * lane + 256 * i;
      const float4 o = make_float4(v[i].x * rs * g4[i].x + b4[i].x, v[i].y * rs * g4[i].y + b4[i].y,
                                   v[i].z * rs * g4[i].z + b4[i].z, v[i].w * rs * g4[i].w + b4[i].w);
      if (l == 0) {
        *(float4*)(XA + (size_t)row * D_ + n) = o;
        write_u_row(p, 1, row, o, n);
      } else *(float4*)(orow + n) = o;
    }
  }
  if (l == 0) conv_batch(p.in[6] + (size_t)1024 * 3968, (bf16_t*)(p.ws + OFF_WINT1), 1024, 3968, 1, (float*)smem, tid);
}

constexpr int NPHASE = 23;
DEV void run_phase(const P& p, int ph, char* smem) {
  if (ph == 0) { phase_mod(p, smem); return; }
  const int l = (ph - 1) / 11, k = (ph - 1) % 11;
  switch (k) {
    case 0: phase_in(p, l, smem); break;
    case 1: phase_prep(p, l, smem); break;
    case 2: phase_scan(p, l, smem, 0); break;
    case 3: phase_post(p, l, smem); break;
    case 4: phase_merge(p, l, smem); break;
    case 5: phase_out(p, l, smem); break;
    case 6: phase_ln1(p, l, smem); break;
    case 7: phase_topk(p, l, smem); break;
    case 8: phase_eup(p, l, smem); break;
    case 9: phase_edown(p, l, smem); break;
    default: phase_ln2(p, l, smem); break;
  }
}

#define XB_TMO      128
#define XB_XCNT(j)  (256  + 64 * (j))
#define XB_XSUB(j)  (1280 + 64 * (j))
#define XB_XGEN(j)  (2304 + 64 * (j))
#define XB_TOP      3328
#define XB_TOPGEN   3392
#define XCD_BAR_WORDS 3456
#define XB_SPIN_CAP (1u << 22)
#define LAS __attribute__((address_space(3)))
DEV unsigned xb_ld(unsigned* p) { return __hip_atomic_load(p, __ATOMIC_RELAXED, __HIP_MEMORY_SCOPE_AGENT); }
DEV unsigned xb_add(unsigned* p, unsigned v) { return __hip_atomic_fetch_add(p, v, __ATOMIC_RELAXED, __HIP_MEMORY_SCOPE_AGENT); }
DEV unsigned xb_xcc_id() { return (unsigned)__builtin_amdgcn_s_getreg((3 << 11) | 20) & 0xFu; }
#define XB_SPIN(cond, bar) do { unsigned _sp = 0; while (cond) { __builtin_amdgcn_s_sleep(1); \
    if ((++_sp & 255u) == 0u) { if (xb_ld(&(bar)[XB_TMO])) break; if (_sp > XB_SPIN_CAP) { atomicAdd(&(bar)[XB_TMO], 1u); break; } } } } while (0)
struct XcdBarrier {
  unsigned* bar;
  unsigned x;
  volatile LAS unsigned* st;
};
DEV XcdBarrier xcd_barrier_post(unsigned* bar, volatile LAS unsigned* st) {
  XcdBarrier b; b.bar = bar; b.x = xb_xcc_id(); b.st = st;
  if (threadIdx.x == 0) (void)xb_add(&bar[XB_XCNT(b.x)], 1u);
  return b;
}
DEV void xcd_barrier_complete(unsigned* bar, unsigned x, unsigned& nloc, unsigned& nx) {
  const unsigned G = gridDim.x * gridDim.y * gridDim.z;
  unsigned sum, cnt, mine, sp = 0u;
  for (;;) {
    sum = 0u; cnt = 0u; mine = 0u;
#pragma unroll
    for (unsigned j = 0; j < 16; ++j) { const unsigned c = xb_ld(&bar[XB_XCNT(j)]); sum += c; cnt += (c > 0u) ? 1u : 0u; mine = (j == x) ? c : mine; }
    if (sum == G) break;
    __builtin_amdgcn_s_sleep(1);
    if ((++sp & 255u) == 0u) { if (xb_ld(&bar[XB_TMO])) break; if (sp > XB_SPIN_CAP) { atomicAdd(&bar[XB_TMO], 1u); break; } }
  }
  nloc = mine > 0u ? mine : 1u; nx = cnt > 0u ? cnt : 1u;
}
DEV void xcd_barrier(const XcdBarrier& b) {
  asm volatile("s_waitcnt vmcnt(0)" ::: "memory");
  __syncthreads();
  if (threadIdx.x == 0) {
    unsigned* bar = b.bar;
    __builtin_amdgcn_s_waitcnt(0);
    unsigned nloc = b.st[0], nx = b.st[1];
    if (nloc == 0u) { xcd_barrier_complete(bar, b.x, nloc, nx); b.st[0] = nloc; b.st[1] = nx; }
    const unsigned old = xb_add(&bar[XB_XSUB(b.x)], 1u);
    const unsigned gen = old / nloc;
    if (old + 1u == (gen + 1u) * nloc) {
      __builtin_amdgcn_fence(__ATOMIC_RELEASE, "agent");
      asm volatile("s_waitcnt vmcnt(0)" ::: "memory");
      const unsigned og = xb_add(&bar[XB_TOP], 1u);
      const unsigned tg = og / nx;
      if (og + 1u == (tg + 1u) * nx) xb_add(&bar[XB_TOPGEN], 1u);
      else XB_SPIN(xb_ld(&bar[XB_TOPGEN]) == tg, bar);
      __builtin_amdgcn_fence(__ATOMIC_ACQUIRE, "agent");
      xb_add(&bar[XB_XGEN(b.x)], 1u);
      asm volatile("s_waitcnt vmcnt(0)" ::: "memory");
    } else {
      XB_SPIN(xb_ld(&bar[XB_XGEN(b.x)]) == gen, bar);
      __builtin_amdgcn_fence(__ATOMIC_ACQUIRE, "agent");
      asm volatile("s_waitcnt vmcnt(0)" ::: "memory");
    }
  }
  __syncthreads();
}

#ifndef REPMASK
#define REPMASK 0
#endif
template <int L>
DEV void run_layer(const P& p, char* smem, const XcdBarrier& xb) {
  phase_in(p, L, smem);
  xcd_barrier(xb);
  if (REPMASK & (1 << 0)) { phase_in(p, L, smem); xcd_barrier(xb); }
  phase_prep(p, L, smem);
  xcd_barrier(xb);
  phase_prep2(p, L, smem);
  xcd_barrier(xb);
  if (REPMASK & (1 << 1)) { phase_prep(p, L, smem); xcd_barrier(xb); phase_prep2(p, L, smem); xcd_barrier(xb); }
  phase_scan(p, L, smem, 0);
  xcd_barrier(xb);
  if (REPMASK & (1 << 2)) { phase_scan(p, L, smem, 1); xcd_barrier(xb); }
  phase_post(p, L, smem);
  xcd_barrier(xb);
  if (REPMASK & (1 << 3)) { phase_post(p, L, smem); xcd_barrier(xb); }
  phase_merge(p, L, smem);
  xcd_barrier(xb);
  if (REPMASK & (1 << 4)) { phase_merge(p, L, smem); xcd_barrier(xb); }
  phase_out(p, L, smem);
  xcd_barrier(xb);
  if (REPMASK & (1 << 5)) { phase_out(p, L, smem); xcd_barrier(xb); }
  phase_ln1(p, L, smem);
  xcd_barrier(xb);
  if (REPMASK & (1 << 6)) { phase_ln1(p, L, smem); xcd_barrier(xb); }
  phase_topk(p, L, smem);
  xcd_barrier(xb);
  if (REPMASK & (1 << 7)) { phase_topk(p, L, smem); xcd_barrier(xb); }
  phase_eup(p, L, smem);
  xcd_barrier(xb);
  if (REPMASK & (1 << 8)) { phase_eup(p, L, smem); xcd_barrier(xb); }
  phase_edown(p, L, smem);
  xcd_barrier(xb);
  if (REPMASK & (1 << 9)) { phase_edown(p, L, smem); xcd_barrier(xb); }
  phase_ln2(p, L, smem);
}

__global__ void __launch_bounds__(256, 2) mega(P p) {
  __shared__ __attribute__((aligned(16))) char smem[SMEM_BYTES];
  __shared__ uint4 xb_words;
  cg::grid_group grid = cg::this_grid();
  if (threadIdx.x == 0) xb_words = make_uint4(0u, 0u, 0u, 0u);
  __syncthreads();
  XcdBarrier xb = xcd_barrier_post((unsigned*)(p.ws + OFF_BAR), (volatile LAS unsigned*)&xb_words);
  phase_mod(p, smem);
  if (p.ws == nullptr) grid.sync();
  xcd_barrier(xb);
  phase_u(p, smem);
  xcd_barrier(xb);
  run_layer<0>(p, smem, xb);
  xcd_barrier(xb);
  run_layer<1>(p, smem, xb);
}

#ifdef MULTI_LAUNCH
template <int K>
__global__ void __launch_bounds__(256) phase_kernel(P p, int l) {
  __shared__ __attribute__((aligned(16))) char smem[SMEM_BYTES];
  if (K == -1) phase_mod(p, smem);
  if (K == 0) phase_in(p, l, smem);
  if (K == 1) phase_prep(p, l, smem);
  if (K == 2) phase_scan(p, l, smem, 0);
  if (K == 3) phase_post(p, l, smem);
  if (K == 4) phase_merge(p, l, smem);
  if (K == 5) phase_out(p, l, smem);
  if (K == 6) phase_ln1(p, l, smem);
  if (K == 7) phase_topk(p, l, smem);
  if (K == 8) phase_eup(p, l, smem);
  if (K == 9) phase_edown(p, l, smem);
  if (K == 10) phase_ln2(p, l, smem);
}
#endif

extern "C" void kernel_launch(void* const* d_in, const int* in_sizes, int n_in, void* d_out, int out_size,
                              void* d_ws, size_t ws_size, hipStream_t stream) {
  static int grid_blocks = 0;
  if (!grid_blocks) {
    int dev = 0, cus = 0, per_cu = 0;
    hipGetDevice(&dev);
    hipDeviceGetAttribute(&cus, hipDeviceAttributeMultiprocessorCount, dev);
    hipOccupancyMaxActiveBlocksPerMultiprocessor(&per_cu, mega, 256, 0);
    if (per_cu > 2) per_cu = 2;
    if (per_cu < 1) per_cu = 1;
    grid_blocks = cus * per_cu;
  }
  P p{};
  for (int i = 0; i < 36; ++i) p.in[i] = (const float*)d_in[i];
  p.out = (float*)d_out;
  p.ws = (char*)d_ws;
  if (ws_size < WS_NEED) fprintf(stderr, "workspace too small: %zu < %zu\n", ws_size, WS_NEED);
#ifdef MULTI_LAUNCH
  const dim3 g(grid_blocks), bk(256);
  hipLaunchKernelGGL(phase_kernel<-1>, g, bk, 0, stream, p, 0);
  for (int l = 0; l < 2; ++l) {
    hipLaunchKernelGGL(phase_kernel<0>, g, bk, 0, stream, p, l);
    hipLaunchKernelGGL(phase_kernel<1>, g, bk, 0, stream, p, l);
    hipLaunchKernelGGL(phase_kernel<2>, g, bk, 0, stream, p, l);
    hipLaunchKernelGGL(phase_kernel<3>, g, bk, 0, stream, p, l);
    hipLaunchKernelGGL(phase_kernel<4>, g, bk, 0, stream, p, l);
    hipLaunchKernelGGL(phase_kernel<5>, g, bk, 0, stream, p, l);
    hipLaunchKernelGGL(phase_kernel<6>, g, bk, 0, stream, p, l);
    hipLaunchKernelGGL(phase_kernel<7>, g, bk, 0, stream, p, l);
    hipLaunchKernelGGL(phase_kernel<8>, g, bk, 0, stream, p, l);
    hipLaunchKernelGGL(phase_kernel<9>, g, bk, 0, stream, p, l);
    hipLaunchKernelGGL(phase_kernel<10>, g, bk, 0, stream, p, l);
  }
#else
  hipMemsetAsync((char*)d_ws + OFF_BAR, 0, XCD_BAR_WORDS * 4, stream);
  void* args[] = {&p};
  hipError_t e = hipLaunchCooperativeKernel((void*)mega, dim3(grid_blocks), dim3(256), args, 0, stream);
  if (e != hipSuccess) fprintf(stderr, "cooperative launch failed: %s (grid %d)\n", hipGetErrorString(e), grid_blocks);
#endif
}
```

```cpp
#include <hip/hip_runtime.h>
#include <hip/hip_cooperative_groups.h>
#include <stdint.h>
#include <stdio.h>
namespace cg = cooperative_groups;

typedef unsigned short bf16_t;
using bf16x8 = __attribute__((ext_vector_type(8))) short;
using f32x16 = __attribute__((ext_vector_type(16))) float;
typedef unsigned long long u64;
#define DEV __device__ __forceinline__

constexpr int NB_ = 16, T_ = 2304, NC_ = 256, NL_ = 2048, D_ = 1024, ROWS_ = NB_ * T_;
constexpr float ALPHA = 1.41421356237309515f;
constexpr size_t MiB = 1ull << 20;
constexpr size_t OFF_MOD = 0, OFF_COS = 1 * MiB, OFF_SIN = 1 * MiB + 262144, OFF_AFF = 2 * MiB,
                 OFF_IDX = 5 * MiB, OFF_GATE = 5 * MiB + 512 * 1024;
constexpr size_t OFF_XA = 6 * MiB, OFF_ZA = 150 * MiB, OFF_ZB = 231 * MiB, OFF_ZC = 303 * MiB, OFF_ZD = 393 * MiB,
                 OFF_RWW = 429 * MiB, OFF_RWA = 501 * MiB, OFF_RWR = 537 * MiB, OFF_RWG = 609 * MiB;
constexpr size_t WS_NEED = 645 * MiB;
constexpr size_t OFF_CNT = 1 * MiB - 256;
constexpr size_t OFF_BAR = 900 * 1024;
constexpr size_t OFF_LW = 1 * MiB + 512 * 1024;
constexpr size_t OFF_SCH = 4 * MiB + 512 * 1024;
constexpr size_t OFF_WINT = OFF_RWW;
constexpr size_t OFF_WGT = OFF_ZA + 40 * MiB;
constexpr size_t OFF_WBT = OFF_WGT + 8 * MiB;
constexpr size_t OFF_WOT = OFF_WBT + 2 * MiB;
constexpr size_t OFF_U = OFF_RWR;
constexpr size_t OFF_TCNT = OFF_RWG;
constexpr size_t OFF_TLIST = OFF_RWG + 1 * MiB;
constexpr size_t OFF_WINT1 = 480 * MiB;
constexpr size_t OFF_YEXP = 335 * MiB;
constexpr size_t OFF_XS = 400 * MiB;
constexpr size_t OFF_WE2T = OFF_ZC, OFF_WE1T = OFF_ZC + 32 * MiB, OFF_WE3T = OFF_ZC + 64 * MiB;
constexpr int SMEM_BYTES = 73728 + 16;
constexpr size_t OFF_Y0 = OFF_ZA, OFF_H = OFF_ZA, OFF_BR = OFF_RWW, OFF_MRG = OFF_RWR, OFF_FCTX = OFF_RWG;
constexpr size_t OUT_Y1 = 0, OUT_Y2 = 36 * MiB, OUT_ATQ = 72 * MiB, OUT_ATK = 90 * MiB, OUT_ATO = 99 * MiB;
constexpr size_t RWSZ = (size_t)ROWS_ * 256;

struct P {
  const float* in[36];
  float* out;
  char* ws;
};

DEV int opaque_tid() {
  int t = threadIdx.x;
  asm volatile("" : "+v"(t));
  return t;
}
DEV float bf2f(bf16_t v) { return __uint_as_float(((unsigned)v) << 16); }
typedef float f2_t __attribute__((ext_vector_type(2)));
typedef __bf16 b2_t __attribute__((ext_vector_type(2)));
DEV unsigned pack2(float a, float b) {
  f2_t v = {a, b};
  b2_t r = __builtin_convertvector(v, b2_t);
  return __builtin_bit_cast(unsigned, r);
}
DEV bf16_t f2bf(float f) { return (bf16_t)(pack2(f, 0.f) & 0xFFFFu); }
DEV float sigmoidf_(float x) { return 1.f / (1.f + __expf(-x)); }
DEV float siluf_(float x) { return x / (1.f + __expf(-x)); }
DEV float dpp_add_(float v, const int ctrl_sel) {
  int x = __float_as_int(v);
  int y = (ctrl_sel == 0)   ? __builtin_amdgcn_update_dpp(0, x, 0xB1, 0xF, 0xF, true)
          : (ctrl_sel == 1) ? __builtin_amdgcn_update_dpp(0, x, 0x4E, 0xF, 0xF, true)
          : (ctrl_sel == 2) ? __builtin_amdgcn_update_dpp(0, x, 0x141, 0xF, 0xF, true)
                            : __builtin_amdgcn_update_dpp(0, x, 0x140, 0xF, 0xF, true);
  return v + __int_as_float(y);
}
DEV float wave_sum(float v) {
  v = dpp_add_(v, 0);
  v = dpp_add_(v, 1);
  v = dpp_add_(v, 2);
  v = dpp_add_(v, 3);
  const int x = __float_as_int(v);
  const float s0 = __int_as_float(__builtin_amdgcn_readlane(x, 0)), s1 = __int_as_float(__builtin_amdgcn_readlane(x, 16));
  const float s2 = __int_as_float(__builtin_amdgcn_readlane(x, 32)), s3 = __int_as_float(__builtin_amdgcn_readlane(x, 48));
  return (s0 + s1) + (s2 + s3);
}
DEV float reduce8(float v) {
  v = dpp_add_(v, 0);
  v = dpp_add_(v, 1);
  v = dpp_add_(v, 2);
  return v;
}
DEV float reduce16(float v) { return dpp_add_(reduce8(v), 3); }
DEV void unpack8(const uint4& u, float (&f)[8]) {
  f[0] = __uint_as_float(u.x << 16); f[1] = __uint_as_float(u.x & 0xFFFF0000u);
  f[2] = __uint_as_float(u.y << 16); f[3] = __uint_as_float(u.y & 0xFFFF0000u);
  f[4] = __uint_as_float(u.z << 16); f[5] = __uint_as_float(u.z & 0xFFFF0000u);
  f[6] = __uint_as_float(u.w << 16); f[7] = __uint_as_float(u.w & 0xFFFF0000u);
}
DEV uint4 pack8(const float (&f)[8]) {
  uint4 u;
  u.x = pack2(f[0], f[1]); u.y = pack2(f[2], f[3]); u.z = pack2(f[4], f[5]); u.w = pack2(f[6], f[7]);
  return u;
}
DEV void ld8f(const float* p, float (&f)[8]) {
  float4 a = *(const float4*)p, b = *(const float4*)(p + 4);
  f[0] = a.x; f[1] = a.y; f[2] = a.z; f[3] = a.w; f[4] = b.x; f[5] = b.y; f[6] = b.z; f[7] = b.w;
}
DEV float f4c(const float4& v, int c) { return c == 0 ? v.x : (c == 1 ? v.y : (c == 2 ? v.z : v.w)); }

DEV const float* xin_row(const P& p, int l, int row) {
  if (l == 0) {
    int b = row / T_, t = row - b * T_;
    return t < NC_ ? p.in[2] + ((size_t)(b * NC_ + t)) * D_ : p.in[0] + ((size_t)(b * NL_ + t - NC_)) * D_;
  }
  return (const float*)(p.ws + OFF_XA) + (size_t)row * D_;
}
DEV const float* mod_row(const P& p, int l, int row) {
  int b = row / T_, t = row - b * T_;
  return (const float*)(p.ws + OFF_MOD) + (size_t)(l * 17 + (t < NC_ ? 16 : b)) * 6144;
}
DEV bf16_t* u2_row(const P& p, int row) {
  return (row < 18432) ? (bf16_t*)(p.ws + OFF_ZD) + (size_t)row * D_ : (bf16_t*)(p.ws + OFF_RWA) + (size_t)(row - 18432) * D_;
}
DEV int map_row(int l, int mrow) { return l == 0 ? mrow : (mrow >> 11) * T_ + NC_ + (mrow & 2047); }
DEV int n_mrows(int l) { return l == 0 ? ROWS_ : NB_ * NL_; }

DEV void conv_tile(const float* src, bf16_t* dst, int K, int N, int nmat, int t, float* lds, const int tid) {
  const int tn = N >> 6, tpm = (K >> 6) * tn;
  const int m = t / tpm, rem = t - m * tpm, k0 = (rem / tn) << 6, n0 = (rem % tn) << 6;
  const float* S = src + (size_t)m * K * N;
  bf16_t* Dd = dst + (size_t)m * K * N;
  __syncthreads();
#pragma unroll
  for (int ps = 0; ps < 4; ++ps) {
    int kr = (tid >> 4) + 16 * ps, nq = tid & 15;
    float4 v = *(const float4*)(S + (size_t)(k0 + kr) * N + n0 + 4 * nq);
    float* d = lds + kr * 65 + 4 * nq;
    d[0] = v.x; d[1] = v.y; d[2] = v.z; d[3] = v.w;
  }
  __syncthreads();
#pragma unroll
  for (int ps = 0; ps < 2; ++ps) {
    int c = tid + 256 * ps, n = c >> 3, kc = c & 7;
    const float* sp = lds + (8 * kc) * 65 + n;
    uint4 o;
    o.x = pack2(sp[0], sp[65]);
    o.y = pack2(sp[2 * 65], sp[3 * 65]);
    o.z = pack2(sp[4 * 65], sp[5 * 65]);
    o.w = pack2(sp[6 * 65], sp[7 * 65]);
    *(uint4*)(Dd + (size_t)(n0 + n) * K + k0 + 8 * kc) = o;
  }
}
DEV void conv_batch(const float* src, bf16_t* dst, int K, int N, int nmat, float* lds, const int tid) {
  const int nt = nmat * (K >> 6) * (N >> 6);
  for (int t = blockIdx.x; t < nt; t += gridDim.x) conv_tile(src, dst, K, N, nmat, t, lds, tid);
}

struct GemmSmem {
  bf16_t a[2][128 * 40];
  bf16_t b[2][2][128 * 40];
};

typedef unsigned u4v __attribute__((ext_vector_type(4)));
typedef float f4v __attribute__((ext_vector_type(4)));
struct ALModX {
  const float* xp[2];
  const float* mp[2];
  struct Raw { f4v x00, x01, x10, x11, h0, h1, s0, s1; };
  template <int MI>
  DEV void issue(int k, Raw& rw) const {
    rw.h0 = *(const f4v*)(mp[0] + k); rw.h1 = *(const f4v*)(mp[0] + k + 4);
    rw.s0 = *(const f4v*)(mp[0] + 1024 + k); rw.s1 = *(const f4v*)(mp[0] + 1024 + k + 4);
    rw.x00 = *(const f4v*)(xp[0] + k); rw.x01 = *(const f4v*)(xp[0] + k + 4);
    if (MI > 1) { rw.x10 = *(const f4v*)(xp[1] + k); rw.x11 = *(const f4v*)(xp[1] + k + 4); }
  }
  DEV u4v cvt(const f4v& x0, const f4v& x1, const Raw& rw) const {
    u4v o;
    o.x = pack2(x0.x * (1.f + rw.s0.x) + rw.h0.x, x0.y * (1.f + rw.s0.y) + rw.h0.y);
    o.y = pack2(x0.z * (1.f + rw.s0.z) + rw.h0.z, x0.w * (1.f + rw.s0.w) + rw.h0.w);
    o.z = pack2(x1.x * (1.f + rw.s1.x) + rw.h1.x, x1.y * (1.f + rw.s1.y) + rw.h1.y);
    o.w = pack2(x1.z * (1.f + rw.s1.z) + rw.h1.z, x1.w * (1.f + rw.s1.w) + rw.h1.w);
    return o;
  }
  template <int MI>
  DEV void finish(const Raw& rw, u4v& a0, u4v& a1) const {
    a0 = cvt(rw.x00, rw.x01, rw);
    if (MI > 1) a1 = cvt(rw.x10, rw.x11, rw);
  }
};
struct ALBf {
  const bf16_t* ap[2];
  struct Raw { u4v v0, v1; };
  template <int MI>
  DEV void issue(int k, Raw& rw) const {
    rw.v0 = *(const u4v*)(ap[0] + k);
    if (MI > 1) rw.v1 = *(const u4v*)(ap[1] + k);
  }
  template <int MI>
  DEV void finish(const Raw& rw, u4v& a0, u4v& a1) const {
    a0 = rw.v0;
    if (MI > 1) a1 = rw.v1;
  }
};

struct ALBfIdx {
  const bf16_t* base;
  unsigned off[2];
  struct Raw { u4v v0, v1; };
  template <int MI>
  DEV void issue(int k, Raw& rw) const {
    rw.v0 = *(const u4v*)(base + (off[0] + (unsigned)k));
    if (MI > 1) rw.v1 = *(const u4v*)(base + (off[1] + (unsigned)k));
  }
  template <int MI>
  DEV void finish(const Raw& rw, u4v& a0, u4v& a1) const {
    a0 = rw.v0;
    if (MI > 1) a1 = rw.v1;
  }
};

template <int NBM, int MI, class AL>
DEV void gemm_core(const AL& al, const bf16_t* B0, const bf16_t* B1, int ldb, int K, GemmSmem* sm,
                   f32x16 (&acc)[NBM][MI][2], const int tid) {
  const int lane = tid & 63, w = tid >> 6, wm = w >> 1, wn = w & 1, r = lane & 31, h = lane >> 5;
  typedef typename AL::Raw RawT;
  struct RB { u4v b0, b1, b2, b3; };
  RawT rawA, rawB;
  RB rbA, rbB;
  const bf16_t* Bp0 = B0 + (size_t)(tid >> 2) * ldb + 8 * (tid & 3);
  const bf16_t* Bp1 = (NBM > 1) ? (B1 + (size_t)(tid >> 2) * ldb + 8 * (tid & 3)) : Bp0;
  const size_t bstep = (size_t)64 * ldb;
  auto gload = [&](int k0, RawT& raw, RB& rb) __attribute__((always_inline)) {
    al.template issue<MI>(k0 + 8 * (tid & 3), raw);
    rb.b0 = *(const u4v*)(Bp0 + k0);
    rb.b1 = *(const u4v*)(Bp0 + k0 + bstep);
    if (NBM > 1) {
      rb.b2 = *(const u4v*)(Bp1 + k0);
      rb.b3 = *(const u4v*)(Bp1 + k0 + bstep);
    }
  };
  auto lstore = [&](int buf, const RawT& raw, const RB& rb) __attribute__((always_inline)) {
    u4v a0, a1;
    al.template finish<MI>(raw, a0, a1);
    const int o0 = (tid >> 2) * 40 + 8 * (tid & 3), o1 = o0 + 64 * 40;
    *(u4v*)&sm->a[buf][o0] = a0;
    if (MI > 1) *(u4v*)&sm->a[buf][o1] = a1;
    *(u4v*)&sm->b[buf][0][o0] = rb.b0;
    *(u4v*)&sm->b[buf][0][o1] = rb.b1;
    if (NBM > 1) {
      *(u4v*)&sm->b[buf][1][o0] = rb.b2;
      *(u4v*)&sm->b[buf][1][o1] = rb.b3;
    }
  };
  auto compute = [&](int buf) __attribute__((always_inline)) {
#pragma unroll
    for (int ks = 0; ks < 2; ++ks) {
      bf16x8 af[MI], bfr[NBM][2];
#pragma unroll
      for (int mi = 0; mi < MI; ++mi)
        af[mi] = *(const bf16x8*)&sm->a[buf][(32 * MI * wm + 32 * mi + r) * 40 + ks * 16 + 8 * h];
#pragma unroll
      for (int nb = 0; nb < NBM; ++nb)
#pragma unroll
        for (int ni = 0; ni < 2; ++ni)
          bfr[nb][ni] = *(const bf16x8*)&sm->b[buf][nb][(64 * wn + 32 * ni + r) * 40 + ks * 16 + 8 * h];
#pragma unroll
      for (int nb = 0; nb < NBM; ++nb)
#pragma unroll
        for (int mi = 0; mi < MI; ++mi)
#pragma unroll
          for (int ni = 0; ni < 2; ++ni)
            acc[nb][mi][ni] = __builtin_amdgcn_mfma_f32_32x32x16_bf16(af[mi], bfr[nb][ni], acc[nb][mi][ni], 0, 0, 0);
    }
  };
  const int KT = K >> 5;
  const int klast = K - 32;
  gload(0, rawA, rbA);
  gload(32, rawB, rbB);
  lstore(0, rawA, rbA);
  __syncthreads();
  for (int kt = 0; kt < KT; kt += 2) {
    gload(min((kt + 2) << 5, klast), rawA, rbA);
    compute(0);
    lstore(1, rawB, rbB);
    __syncthreads();
    gload(min((kt + 3) << 5, klast), rawB, rbB);
    compute(1);
    lstore(0, rawA, rbA);
    __syncthreads();
  }
}

struct GemmSmem64 {
  bf16_t a[2][128 * 72];
  bf16_t b[2][128 * 72];
};
template <int MI>
DEV void gemm64(const bf16_t* const (&ap)[4], const bf16_t* B, int ldb, int K, GemmSmem64* sm, f32x16 (&acc)[1][MI][2],
                const int tid) {
  const int lane = tid & 63, w = tid >> 6, wm = w >> 1, wn = w & 1, r = lane & 31, h = lane >> 5;
  struct St { u4v a0, a1, a2, a3, b0, b1, b2, b3; };
  St sA, sB;
  const int kc8 = 8 * (tid & 7);
  const bf16_t* Bp = B + (size_t)(tid >> 3) * ldb + kc8;
  const size_t bstep = (size_t)32 * ldb;
  auto gload = [&](int k0, St& st) __attribute__((always_inline)) {
    st.a0 = *(const u4v*)(ap[0] + k0 + kc8);
    st.a1 = *(const u4v*)(ap[1] + k0 + kc8);
    if (MI > 1) {
      st.a2 = *(const u4v*)(ap[2] + k0 + kc8);
      st.a3 = *(const u4v*)(ap[3] + k0 + kc8);
    }
    st.b0 = *(const u4v*)(Bp + k0);
    st.b1 = *(const u4v*)(Bp + k0 + bstep);
    st.b2 = *(const u4v*)(Bp + k0 + 2 * bstep);
    st.b3 = *(const u4v*)(Bp + k0 + 3 * bstep);
  };
  auto lstore = [&](int buf, const St& st) __attribute__((always_inline)) {
    const int o0 = (tid >> 3) * 72 + kc8;
    *(u4v*)&sm->a[buf][o0] = st.a0;
    *(u4v*)&sm->a[buf][o0 + 32 * 72] = st.a1;
    if (MI > 1) {
      *(u4v*)&sm->a[buf][o0 + 64 * 72] = st.a2;
      *(u4v*)&sm->a[buf][o0 + 96 * 72] = st.a3;
    }
    *(u4v*)&sm->b[buf][o0] = st.b0;
    *(u4v*)&sm->b[buf][o0 + 32 * 72] = st.b1;
    *(u4v*)&sm->b[buf][o0 + 64 * 72] = st.b2;
    *(u4v*)&sm->b[buf][o0 + 96 * 72] = st.b3;
  };
  auto compute = [&](int buf) __attribute__((always_inline)) {
#pragma unroll
    for (int ks = 0; ks < 4; ++ks) {
      bf16x8 af[MI], bfr[2];
#pragma unroll
      for (int mi = 0; mi < MI; ++mi)
        af[mi] = *(const bf16x8*)&sm->a[buf][(32 * MI * wm + 32 * mi + r) * 72 + ks * 16 + 8 * h];
#pragma unroll
      for (int ni = 0; ni < 2; ++ni) bfr[ni] = *(const bf16x8*)&sm->b[buf][(64 * wn + 32 * ni + r) * 72 + ks * 16 + 8 * h];
#pragma unroll
      for (int mi = 0; mi < MI; ++mi)
#pragma unroll
        for (int ni = 0; ni < 2; ++ni)
          acc[0][mi][ni] = __builtin_amdgcn_mfma_f32_32x32x16_bf16(af[mi], bfr[ni], acc[0][mi][ni], 0, 0, 0);
    }
  };
  const int KT = K >> 6;
  const int klast = K - 64;
  gload(0, sA);
  gload(64, sB);
  lstore(0, sA);
  __syncthreads();
  for (int kt = 0; kt < KT; kt += 2) {
    gload(min((kt + 2) << 6, klast), sA);
    compute(0);
    lstore(1, sB);
    __syncthreads();
    gload(min((kt + 3) << 6, klast), sB);
    compute(1);
    lstore(0, sA);
    __syncthreads();
  }
}

template <int NBM, int MI>
DEV void acc_zero(f32x16 (&acc)[NBM][MI][2]) {
#pragma unroll
  for (int nb = 0; nb < NBM; ++nb)
#pragma unroll
    for (int mi = 0; mi < MI; ++mi)
#pragma unroll
      for (int ni = 0; ni < 2; ++ni)
#pragma unroll
        for (int e = 0; e < 16; ++e) acc[nb][mi][ni][e] = 0.f;
}
#define ACC_ROW(mi, reg) (64 * wm + 32 * (mi) + ((reg) & 3) + 8 * ((reg) >> 2) + 4 * h)
#define ACC_COL(ni) (64 * wn + 32 * (ni) + r)
#define ACC_IDS                                                                                     \
  const int tid = opaque_tid(), lane = tid & 63, w = tid >> 6, wm = w >> 1, wn = w & 1, r = lane & 31, \
            h = lane >> 5;                                                                          \
  (void)tid; (void)lane; (void)w; (void)wm; (void)wn; (void)r; (void)h;

DEV void phase_mod(const P& p, char* smem) {
  float* sc = (float*)smem;
  float* red = sc + 17 * 256;
  const int tid = opaque_tid(), kg = tid >> 5, cn = tid & 31;
  float* MOD = (float*)(p.ws + OFF_MOD);
  for (int i = blockIdx.x * 256 + tid; i < 4 * 8448; i += gridDim.x * 256) ((int*)(p.ws + OFF_SCH))[i] = 0;
  for (int task = blockIdx.x; task < 384; task += gridDim.x) {
    const int l = task / 192, n0 = (task % 192) * 32;
    const float* W = p.in[4] + (size_t)l * 1024 * 6144;
    float acc[17];
#pragma unroll
    for (int i = 0; i < 17; ++i) acc[i] = 0.f;
    for (int s = 0; s < 4; ++s) {
      __syncthreads();
      for (int i = tid; i < 17 * 256; i += 256) {
        int rr = i >> 8, k = i & 255;
        float c = (rr < 16) ? p.in[1][rr * 1024 + s * 256 + k] : p.in[3][s * 256 + k];
        sc[i] = siluf_(c);
      }
      __syncthreads();
#pragma unroll 8
      for (int kk = 0; kk < 32; ++kk) {
        int k = kg * 32 + kk;
        float wv = W[(size_t)(s * 256 + k) * 6144 + n0 + cn];
#pragma unroll
        for (int rr = 0; rr < 17; ++rr) acc[rr] += sc[rr * 256 + k] * wv;
      }
    }
#pragma unroll
    for (int rr = 0; rr < 17; ++rr) red[(kg * 17 + rr) * 32 + cn] = acc[rr];
    __syncthreads();
    for (int i = tid; i < 17 * 32; i += 256) {
      int rr = i >> 5, c = i & 31;
      float v = 0.f;
#pragma unroll
      for (int g = 0; g < 8; ++g) v += red[(g * 17 + rr) * 32 + c];
      MOD[(size_t)(l * 17 + rr) * 6144 + n0 + c] = v + p.in[5][l * 6144 + n0 + c];
    }
    __syncthreads();
  }
  float* COS = (float*)(p.ws + OFF_COS);
  float* SIN = (float*)(p.ws + OFF_SIN);
  for (int i = blockIdx.x * 256 + tid; i < 2048 * 32; i += gridDim.x * 256) {
    int n = i >> 5, j = i & 31;
    int rowi = n >> 6, coli = n & 63;
    float inv = powf(10000.f, -(float)(j & 15) / 16.f);
    float ang = (float)(j < 16 ? rowi : coli) * inv;
    COS[i] = cosf(ang);
    SIN[i] = sinf(ang);
  }
  conv_batch(p.in[6], (bf16_t*)(p.ws + OFF_WINT), 1024, 3968, 1, (float*)smem, tid);
  conv_batch(p.in[9], (bf16_t*)(p.ws + OFF_LW), 64, 256, 4, (float*)smem, tid);
  conv_batch(p.in[11], (bf16_t*)(p.ws + OFF_LW) + 65536, 64, 256, 4, (float*)smem, tid);
  conv_batch(p.in[12], (bf16_t*)(p.ws + OFF_LW) + 131072, 128, 256, 2, (float*)smem, tid);
}

DEV bool tile_map(int it, int R, int C, int& rt, int& ct) {
  const int x = blockIdx.x & 7, j = blockIdx.x >> 3, nb8 = gridDim.x >> 3;
  const int q = it * nb8 + j;
  const int s = (q >> 6) * 8 + x, w = q & 63;
  const int c8 = C >> 3;
  if (s >= (R >> 3) * c8) return false;
  const int sr = s / c8, sc = s - sr * c8;
  rt = sr * 8 + (w >> 3);
  ct = sc * 8 + (w & 7);
  return true;
}

DEV void store_rowpair_bf16(bf16_t* base, size_t ld, int R, int c, float ve, float ve1) {
  const bool odd = (c & 1) != 0;
  const float snd = odd ? ve : ve1;
  const float rcv = __int_as_float(__builtin_amdgcn_update_dpp(0, __float_as_int(snd), 0xB1, 0xF, 0xF, true));
  const unsigned pk = odd ? pack2(rcv, ve1) : pack2(ve, rcv);
  *(unsigned*)(base + (size_t)(odd ? R + 1 : R) * ld + (odd ? c - 1 : c)) = pk;
}

DEV void write_u_row(const P& p, int lnext, int row, const float4& x, int n) {
  const float* mr = mod_row(p, lnext, row);
  float4 sh = *(const float4*)(mr + n), sc = *(const float4*)(mr + 1024 + n);
  uint2 o;
  o.x = pack2(x.x * (1.f + sc.x) + sh.x, x.y * (1.f + sc.y) + sh.y);
  o.y = pack2(x.z * (1.f + sc.z) + sh.z, x.w * (1.f + sc.w) + sh.w);
  *(uint2*)((bf16_t*)(p.ws + OFF_U) + (size_t)row * D_ + n) = o;
}
DEV void phase_u(const P& p, char* smem) {
  const int tid = opaque_tid(), n = tid * 4;
  for (int row = blockIdx.x; row < ROWS_; row += gridDim.x) {
    float4 x = *(const float4*)(xin_row(p, 0, row) + n);
    write_u_row(p, 0, row, x, n);
  }
}

DEV void phase_in(const P& p, int l, char* smem) {
  GemmSmem* sm = (GemmSmem*)smem;
  ACC_IDS
  const bf16_t* WT = (const bf16_t*)(p.ws + (l == 0 ? OFF_WINT : OFF_WINT1));
  int mt, np;
  for (int it = 0; tile_map(it, 288, 16, mt, np); ++it) {
    ALBf al;
#pragma unroll
    for (int i = 0; i < 2; ++i) al.ap[i] = (const bf16_t*)(p.ws + OFF_U) + (size_t)(mt * 128 + (tid >> 2) + 64 * i) * D_;
    f32x16 acc[2][2][2];
    acc_zero<2, 2>(acc);
    const bf16_t* B0 = WT + (size_t)(np * 256) * 1024;
    const bf16_t* B1 = (np < 15) ? B0 + (size_t)128 * 1024 : B0;
    gemm_core<2, 2>(al, B0, B1, 1024, 1024, sm, acc, tid);
#pragma unroll
    for (int nb = 0; nb < 2; ++nb) {
      const int nt = 2 * np + nb;
      if (nt < 31) {
        bf16_t* Z;
        int ld, c0;
        if (nt < 9) { Z = (bf16_t*)(p.ws + OFF_ZA); ld = 1152; c0 = nt * 128; }
        else if (nt < 17) { Z = (bf16_t*)(p.ws + OFF_ZB); ld = 1024; c0 = (nt - 9) * 128; }
        else if (nt < 27) { Z = (bf16_t*)(p.ws + OFF_ZC); ld = 1280; c0 = (nt - 17) * 128; }
        else { Z = (bf16_t*)(p.ws + OFF_ZD); ld = 512; c0 = (nt - 27) * 128; }
#pragma unroll
        for (int mi = 0; mi < 2; ++mi)
#pragma unroll
          for (int ni = 0; ni < 2; ++ni)
#pragma unroll
            for (int e = 0; e < 16; e += 2)
              store_rowpair_bf16(Z, ld, mt * 128 + ACC_ROW(mi, e), c0 + ACC_COL(ni), acc[nb][mi][ni][e], acc[nb][mi][ni][e + 1]);
      }
    }
  }
}

DEV float za_mix(const bf16_t* ZA, const float* mu, int b, int t, int col) {
  const bf16_t* z = ZA + ((size_t)b * T_ + t) * 1152 + col;
  float zc = bf2f(z[0]);
  bool hasl = (t != 0 && t != NC_), hasr = (t != NC_ - 1 && t != T_ - 1);
  float zl = hasl ? bf2f(z[-1152]) : 0.f;
  float zr = hasr ? bf2f(z[1152]) : 0.f;
  return zc + mu[col] * (0.5f * (zl + zr) - zc);
}

DEV void za_mix8(const bf16_t* ZA, const float (&mu)[8], int b, int t, int col, float (&o)[8]) {
  const bf16_t* z = ZA + ((size_t)b * T_ + t) * 1152 + col;
  const bool hasl = (t != 0 && t != NC_), hasr = (t != NC_ - 1 && t != T_ - 1);
  const uint4 zero4 = make_uint4(0, 0, 0, 0);
  uint4 uc = *(const uint4*)z;
  uint4 ul = hasl ? *(const uint4*)(z - 1152) : zero4;
  uint4 ur = hasr ? *(const uint4*)(z + 1152) : zero4;
  float c[8], lft[8], rgt[8];
  unpack8(uc, c); unpack8(ul, lft); unpack8(ur, rgt);
#pragma unroll
  for (int j = 0; j < 8; ++j) o[j] = c[j] + mu[j] * (0.5f * (lft[j] + rgt[j]) - c[j]);
}

DEV void phase_prep(const P& p, int l, char* smem) {
  const int tid = opaque_tid(), lane = tid & 63, wv = tid >> 6;
  const bf16_t* ZA = (const bf16_t*)(p.ws + OFF_ZA);
  const bf16_t* ZD = (const bf16_t*)(p.ws + OFF_ZD);
  const float* mu = p.in[7] + l * 1152;
  bf16_t* RWR = (bf16_t*)(p.ws + OFF_RWR);
  bf16_t* RWK = RWR + RWSZ;
  bf16_t* RWV = RWK + RWSZ;
  bf16_t* RWKK = RWV + RWSZ;
  bf16_t* RWBG = (bf16_t*)(p.ws + OFF_RWG) + RWSZ;
  bf16_t* LI = (bf16_t*)((char*)p.out + OUT_Y1);
  bf16_t* ATQ = (bf16_t*)((char*)p.out + OUT_ATQ);
  bf16_t* ATK = (bf16_t*)((char*)p.out + OUT_ATK);
  const float* COS = (const float*)(p.ws + OFF_COS);
  const float* SIN = (const float*)(p.ws + OFF_SIN);
  const int gw = blockIdx.x * 4 + wv, nw = gridDim.x * 4;
  {
    const int c8 = (lane & 31) * 8;
    float mur[8], muk[8], muv[8], kkw[8], rkw[8];
    ld8f(mu + c8, mur); ld8f(mu + 256 + c8, muk); ld8f(mu + 512 + c8, muv);
    ld8f(p.in[13] + l * 256 + c8, kkw); ld8f(p.in[15] + l * 256 + c8, rkw);
#pragma unroll 2
    for (int pr = gw; pr < ROWS_ / 2; pr += nw) {
      const int row = 2 * pr + (lane >> 5);
      const int b = row / T_, t = row - b * T_;
      float rv[8], kv[8], vv[8];
      za_mix8(ZA, mur, b, t, c8, rv);
      za_mix8(ZA, muk, b, t, 256 + c8, kv);
      za_mix8(ZA, muv, b, t, 512 + c8, vv);
      float kkf[8], ss = 0.f, rk = 0.f;
#pragma unroll
      for (int j = 0; j < 8; ++j) { kkf[j] = kv[j] * kkw[j]; ss += kkf[j] * kkf[j]; rk += rv[j] * kv[j] * rkw[j]; }
      ss = reduce8(ss);
      rk = reduce8(rk);
      const float rn = rsqrtf(ss + 1e-12f);
      float bon[8];
#pragma unroll
      for (int j = 0; j < 8; ++j) { kkf[j] *= rn; bon[j] = rk * vv[j]; }
      const size_t o = (size_t)row * 256 + c8;
      *(uint4*)(RWR + o) = pack8(rv);
      *(uint4*)(RWK + o) = pack8(kv);
      *(uint4*)(RWV + o) = pack8(vv);
      *(uint4*)(RWKK + o) = pack8(kkf);
      *(uint4*)(RWBG + o) = pack8(bon);
#pragma unroll
      for (int ps = 0; ps < 2; ++ps) {
        const int id = lane + 64 * ps;
        if (id < 96) {
          const int rs = id / 48, ck = id - rs * 48;
          const int row2 = 2 * pr + rs;
          const int b2 = row2 / T_, t2 = row2 - b2 * T_;
          float mul[8], lv[8];
          ld8f(mu + 768 + ck * 8, mul);
          za_mix8(ZA, mul, b2, t2, 768 + ck * 8, lv);
          if (ck < 16) {
#pragma unroll
            for (int j = 0; j < 8; ++j) lv[j] = tanhf(lv[j]);
          } else if (ck >= 32) {
#pragma unroll
            for (int j = 0; j < 8; ++j) lv[j] = sigmoidf_(lv[j]);
          }
          *(uint4*)(LI + (size_t)row2 * 384 + ck * 8) = pack8(lv);
        }
      }
    }
  }
  {
    const int hc = lane & 7;
    const bool isq = lane < 32, act = lane < 48;
    float gown[8], gpar[8];
    const float* gsrc = (isq ? p.in[23] : p.in[24]) + l * 64;
    ld8f(gsrc + hc * 8, gown);
    ld8f(gsrc + (hc ^ 4) * 8, gpar);
#pragma unroll 2
    for (int row = gw; row < ROWS_; row += nw) {
      const int t = row % T_;
      if (act) {
        const bf16_t* z = ZD + (size_t)row * 512;
        float xo[8], xp[8];
        unpack8(*(const uint4*)(z + lane * 8), xo);
        unpack8(*(const uint4*)(z + (lane ^ 4) * 8), xp);
        float ss = 0.f;
#pragma unroll
        for (int j = 0; j < 8; ++j) ss += xo[j] * xo[j];
        ss = reduce8(ss);
        const float rn = rsqrtf(ss * (1.f / 64.f) + 1e-6f);
        float cs[8], sn[8];
        if (t >= NC_) {
          ld8f(COS + (t - NC_) * 32 + (hc & 3) * 8, cs);
          ld8f(SIN + (t - NC_) * 32 + (hc & 3) * 8, sn);
        } else {
#pragma unroll
          for (int j = 0; j < 8; ++j) { cs[j] = 1.f; sn[j] = 0.f; }
        }
        float o[8];
        const float scl = isq ? 0.125f : 1.f;
#pragma unroll
        for (int j = 0; j < 8; ++j) {
          const float a = xo[j] * rn * gown[j], bq = xp[j] * rn * gpar[j];
          o[j] = ((hc & 4) == 0 ? (a * cs[j] - bq * sn[j]) : (bq * sn[j] + a * cs[j])) * scl;
        }
        if (isq) *(uint4*)(ATQ + (size_t)row * 256 + lane * 8) = pack8(o);
        else *(uint4*)(ATK + (size_t)row * 128 + (lane - 32) * 8) = pack8(o);
      }
    }
  }
}

DEV void phase_prep2(const P& p, int l, char* smem) {
  GemmSmem* sm = (GemmSmem*)smem;
  ACC_IDS
  const bf16_t* LI = (const bf16_t*)((const char*)p.out + OUT_Y1);
  const bf16_t* LW = (const bf16_t*)(p.ws + OFF_LW);
  float* RWW = (float*)(p.ws + OFF_RWW);
  bf16_t* RWA = (bf16_t*)(p.ws + OFF_RWA);
  bf16_t* RWG = (bf16_t*)(p.ws + OFF_RWG);
  bf16_t* RWBG = RWG + RWSZ;
  for (int tile = blockIdx.x; tile < 288 * 10; tile += gridDim.x) {
    const int mt = tile / 10, nt = tile % 10;
    const int kind = nt >> 1, chalf = nt & 1;
    const int K = (kind == 4) ? 128 : 64;
    const int koff = (kind == 4) ? 256 : kind * 64;
    const bf16_t* Bt;
    if (kind < 2) Bt = LW + (size_t)((l * 2 + kind) * 256) * 64;
    else if (kind < 4) Bt = LW + 65536 + (size_t)((l * 2 + (kind - 2)) * 256) * 64;
    else Bt = LW + 131072 + (size_t)(l * 256) * 128;
    Bt += (size_t)(chalf * 128) * K;
    ALBf al;
#pragma unroll
    for (int i = 0; i < 2; ++i) al.ap[i] = LI + (size_t)(mt * 128 + (tid >> 2) + 64 * i) * 384 + koff;
    f32x16 acc[1][2][2];
    acc_zero<1, 2>(acc);
    gemm_core<1, 2>(al, Bt, nullptr, K, K, sm, acc, tid);
    const int d = kind & 1;
#pragma unroll
    for (int ni = 0; ni < 2; ++ni) {
      const int ch = chalf * 128 + ACC_COL(ni);
      const float c0 = (kind < 2) ? p.in[8][(l * 2 + d) * 256 + ch] : ((kind < 4) ? p.in[10][(l * 2 + d) * 256 + ch] : 0.f);
#pragma unroll
      for (int mi = 0; mi < 2; ++mi)
#pragma unroll
        for (int e = 0; e < 16; e += 2) {
          const int R = mt * 128 + ACC_ROW(mi, e);
          const size_t o = (size_t)R * 256 + ch;
          const float v0 = acc[0][mi][ni][e], v1 = acc[0][mi][ni][e + 1];
          if (kind < 2) {
            float x0 = -(c0 + v0), x1 = -(c0 + v1);
            float sp0 = fmaxf(x0, 0.f) + log1pf(__expf(-fabsf(x0))), sp1 = fmaxf(x1, 0.f) + log1pf(__expf(-fabsf(x1)));
            RWW[(size_t)d * RWSZ + o] = __expf(-__expf(-sp0 - 0.5f));
            RWW[(size_t)d * RWSZ + o + 256] = __expf(-__expf(-sp1 - 0.5f));
          } else if (kind < 4) {
            store_rowpair_bf16(RWA + (size_t)d * RWSZ, 256, R, ch, sigmoidf_(c0 + v0), sigmoidf_(c0 + v1));
          } else {
            const float b0 = bf2f(RWBG[o]), b1 = bf2f(RWBG[o + 256]);
            store_rowpair_bf16(RWG, 256, R, ch, v0, v1);
            store_rowpair_bf16(RWBG, 256, R, ch, b0 * v0, b1 * v1);
          }
        }
    }
  }
}

DEV int scan_tok(int d, int j) { return d == 0 ? j : (j < NC_ ? NC_ - 1 - j : (T_ + NC_ - 1) - j); }

DEV float quad_sum(float v) {
  v += __int_as_float(__builtin_amdgcn_update_dpp(0, __float_as_int(v), 0xB1, 0xF, 0xF, true));
  v += __int_as_float(__builtin_amdgcn_update_dpp(0, __float_as_int(v), 0x4E, 0xF, 0xF, true));
  return v;
}

constexpr int SCH = 16;
constexpr int SCHF = SCH * 384;
template <int MIX, int LPR>
DEV void scan_block(const P& p, int l, int task0, float* LB, const int tid) {
  constexpr int NF = 16 / LPR;
  const int lane = tid & 63, wv = tid >> 6;
  const int task = (LPR == 8) ? (task0 >> 1) : task0;
  const int rowbase = (LPR == 8) ? 32 * (task0 & 1) : 0;
  const int d = task & 1, hh = (task >> 1) & 3, b = task >> 3;
  const int c = hh * 64 + lane;
  const int col = rowbase + (64 / LPR) * wv + (lane / LPR), q = lane & (LPR - 1);
  f2_t S2[2 * NF];
#pragma unroll
  for (int i = 0; i < 2 * NF; ++i) S2[i] = (f2_t){0.f, 0.f};
  const float* RWW = (const float*)(p.ws + OFF_RWW) + (size_t)d * RWSZ;
  const bf16_t* RWA = (const bf16_t*)(p.ws + OFF_RWA) + (size_t)d * RWSZ;
  const bf16_t* RWR = (const bf16_t*)(p.ws + OFF_RWR);
  const bf16_t* RWK = RWR + RWSZ;
  const bf16_t* RWV = RWK + RWSZ;
  const bf16_t* RWKK = RWV + RWSZ;
  const bf16_t* ZB = (const bf16_t*)(p.ws + OFF_ZB);
  const bf16_t* ZC = (const bf16_t*)(p.ws + OFF_ZC);
  const float* COS = (const float*)(p.ws + OFF_COS);
  const float* SIN = (const float*)(p.ws + OFF_SIN);
  bf16_t* Y = (MIX == 0) ? (bf16_t*)(p.ws + OFF_Y0)
                         : (MIX == 1 ? (bf16_t*)((char*)p.out + OUT_Y1) : (bf16_t*)((char*)p.out + OUT_Y2));
  Y += (size_t)d * RWSZ;
  float cst0 = 0.f, cst1 = 0.f;
  if (MIX == 0) cst0 = p.in[14][l * 256 + c];
  if (MIX == 1) cst0 = sigmoidf_(p.in[18][(l * 2 + d) * 4 + hh]);
  if (MIX == 2) {
    float h0 = p.in[21][(d * 2 + 0) * 256 + c], h1 = p.in[21][(d * 2 + 1) * 256 + c];
    cst0 = (l == 0) ? 0.f : sigmoidf_(h1 - h0);
    cst1 = 1.f - cst0;
  }
  constexpr int NV = (MIX == 0) ? 6 : (MIX == 1 ? 7 : 3);
  constexpr int SPW = SCH / 4;
  float pf[SPW][NV];
  auto issue = [&](int j0) __attribute__((always_inline)) {
#pragma unroll
    for (int s2 = 0; s2 < SPW; ++s2) {
      const int t = scan_tok(d, j0 + SPW * wv + s2);
      const size_t row = (size_t)b * T_ + t;
      if (MIX == 0) {
        pf[s2][0] = RWW[row * 256 + c];
        pf[s2][1] = bf2f(RWA[row * 256 + c]);
        pf[s2][2] = bf2f(RWR[row * 256 + c]);
        pf[s2][3] = bf2f(RWK[row * 256 + c]);
        pf[s2][4] = bf2f(RWKK[row * 256 + c]);
        pf[s2][5] = bf2f(RWV[row * 256 + c]);
      } else if (MIX == 1) {
        const bf16_t* z = ZB + row * 1024;
        pf[s2][0] = bf2f(z[c]);
        pf[s2][1] = bf2f(z[c ^ 32]);
        pf[s2][2] = bf2f(z[256 + c]);
        pf[s2][3] = bf2f(z[256 + (c ^ 32)]);
        pf[s2][4] = bf2f(z[512 + c]);
        if (t >= NC_) {
          pf[s2][5] = COS[(t - NC_) * 32 + (lane & 31)];
          pf[s2][6] = SIN[(t - NC_) * 32 + (lane & 31)];
        } else {
          pf[s2][5] = 1.f;
          pf[s2][6] = 0.f;
        }
      } else {
        const bf16_t* z = ZC + row * 1280;
        pf[s2][0] = bf2f(z[c]);
        pf[s2][1] = bf2f(z[256 + d * 256 + c]);
        pf[s2][2] = bf2f(z[768 + c]);
      }
    }
  };
  auto commit = [&](float* Lb) __attribute__((always_inline)) {
#pragma unroll
    for (int s2 = 0; s2 < SPW; ++s2) {
      float* Ls = Lb + (SPW * wv + s2) * 384;
      if (MIX == 0) {
        float wd = pf[s2][0], a = pf[s2][1], rv = pf[s2][2], kv = pf[s2][3], kk = pf[s2][4], vv = pf[s2][5];
        Ls[lane] = wd;
        Ls[64 + lane] = kk;
        Ls[128 + lane] = kk * a;
        Ls[192 + lane] = kv * (1.f + (a - 1.f) * cst0);
        Ls[256 + lane] = rv;
        Ls[320 + lane] = vv;
      } else if (MIX == 1) {
        float cs = pf[s2][5], sn = pf[s2][6];
        float qq = (lane < 32) ? (pf[s2][0] * cs - pf[s2][1] * sn) : (pf[s2][1] * sn + pf[s2][0] * cs);
        float kk = (lane < 32) ? (pf[s2][2] * cs - pf[s2][3] * sn) : (pf[s2][3] * sn + pf[s2][2] * cs);
        Ls[lane] = qq;
        Ls[64 + lane] = kk * 0.125f;
        Ls[128 + lane] = pf[s2][4];
      } else {
        float x = pf[s2][1];
        float sg = 1.f / (1.f + __expf(-x));
        Ls[lane] = cst0 + cst1 * sg;
        Ls[128 + lane] = siluf_(pf[s2][0]);
        Ls[192 + lane] = pf[s2][2];
      }
    }
  };
  __syncthreads();
  issue(0);
  commit(LB);
  __syncthreads();
  for (int j0 = 0; j0 < T_; j0 += SCH) {
    const int cb = (j0 / SCH) & 1;
    const float* Lc = LB + cb * SCHF;
    float* Ln = LB + (cb ^ 1) * SCHF;
    if (j0 + SCH < T_) issue(j0 + SCH);
    {
      constexpr int NX = ((MIX == 0) ? 4 : 2) * NF;
      f4v XA[NX], XB[NX], KA[NF], KB[NF];
      float vvA, vvB;
      auto ldk = [&](const float* Ls, f4v (&dst)[NF]) __attribute__((always_inline)) {
        const f4v* L4 = (const f4v*)Ls;
#pragma unroll
        for (int i = 0; i < NF; ++i) dst[i] = L4[16 + NF * q + i];
      };
      auto ldx = [&](const float* Ls, f4v (&X)[NX], float& vv) __attribute__((always_inline)) {
        const f4v* L4 = (const f4v*)Ls;
        if (MIX == 0) {
#pragma unroll
          for (int i = 0; i < NF; ++i) {
            X[i] = L4[NF * q + i];
            X[NF + i] = L4[32 + NF * q + i];
            X[2 * NF + i] = L4[48 + NF * q + i];
            X[3 * NF + i] = L4[64 + NF * q + i];
          }
          vv = Ls[320 + col];
        } else if (MIX == 1) {
#pragma unroll
          for (int i = 0; i < NF; ++i) {
            X[i] = L4[NF * q + i];
            X[NF + i] = L4[16 + NF * q + i];
          }
          vv = Ls[128 + col];
        } else {
#pragma unroll
          for (int i = 0; i < NF; ++i) {
            X[i] = L4[NF * q + i];
            X[NF + i] = L4[32 + NF * q + i];
          }
          vv = Ls[192 + col];
        }
      };
      auto lsum = [&](float v) __attribute__((always_inline)) -> float { return (LPR == 8) ? reduce8(v) : quad_sum(v); };
      auto step = [&](const f4v (&kq)[NF], const f4v (&X)[NX], const float vv) __attribute__((always_inline)) -> float {
        f2_t o2a = {0.f, 0.f}, o2b = {0.f, 0.f};
        if (MIX == 0) {
          f2_t a2 = {0.f, 0.f}, b2 = {0.f, 0.f};
#pragma unroll
          for (int i = 0; i < NF; ++i) {
            a2 += S2[2 * i] * kq[i].lo;
            b2 += S2[2 * i + 1] * kq[i].hi;
          }
          a2 += b2;
          const float nskk = -lsum(a2.x + a2.y);
          const f2_t ns2 = {nskk, nskk}, vv2 = {vv, vv};
#pragma unroll
          for (int i = 0; i < NF; ++i) {
            f2_t s0 = S2[2 * i] * X[i].lo + ns2 * X[NF + i].lo + vv2 * X[2 * NF + i].lo;
            f2_t s1 = S2[2 * i + 1] * X[i].hi + ns2 * X[NF + i].hi + vv2 * X[2 * NF + i].hi;
            S2[2 * i] = s0;
            S2[2 * i + 1] = s1;
            o2a += s0 * X[3 * NF + i].lo;
            o2b += s1 * X[3 * NF + i].hi;
          }
        } else if (MIX == 1) {
          const f2_t gm2 = {cst0, cst0}, vv2 = {vv, vv};
#pragma unroll
          for (int i = 0; i < NF; ++i) {
            f2_t s0 = S2[2 * i] * gm2 + X[NF + i].lo * vv2;
            f2_t s1 = S2[2 * i + 1] * gm2 + X[NF + i].hi * vv2;
            S2[2 * i] = s0;
            S2[2 * i + 1] = s1;
            o2a += s0 * X[i].lo;
            o2b += s1 * X[i].hi;
          }
        } else {
          const f2_t vv2 = {vv, vv};
#pragma unroll
          for (int i = 0; i < NF; ++i) {
            f2_t s0 = (S2[2 * i] - vv2) * X[i].lo + vv2;
            f2_t s1 = (S2[2 * i + 1] - vv2) * X[i].hi + vv2;
            S2[2 * i] = s0;
            S2[2 * i + 1] = s1;
            o2a += s0 * X[NF + i].lo;
            o2b += s1 * X[NF + i].hi;
          }
        }
        o2a += o2b;
        return lsum(o2a.x + o2a.y);
      };
      if (MIX == 0) ldk(Lc, KA);
      else ldx(Lc, XA, vvA);
      float keep = 0.f;
#pragma unroll
      for (int s = 0; s < SCH; ++s) {
        float o;
        if (MIX == 0) {
          ldx(Lc + s * 384, XA, vvA);
          if ((s & 1) == 0) {
            if (s + 1 < SCH) ldk(Lc + (s + 1) * 384, KB);
            __builtin_amdgcn_sched_barrier(0);
            o = step(KA, XA, vvA);
          } else {
            if (s + 1 < SCH) ldk(Lc + (s + 1) * 384, KA);
            __builtin_amdgcn_sched_barrier(0);
            o = step(KB, XA, vvA);
          }
        } else {
          if ((s & 1) == 0) {
            if (s + 1 < SCH) ldx(Lc + (s + 1) * 384, XB, vvB);
            __builtin_amdgcn_sched_barrier(0);
            o = step(KA, XA, vvA);
          } else {
            if (s + 1 < SCH) ldx(Lc + (s + 1) * 384, XA, vvA);
            __builtin_amdgcn_sched_barrier(0);
            o = step(KA, XB, vvB);
          }
        }
        keep = ((s & (LPR - 1)) == q) ? o : keep;
        if ((s & (LPR - 1)) == LPR - 1) {
          const int t = scan_tok(d, j0 + (s & ~(LPR - 1)) + q);
          Y[((size_t)b * T_ + t) * 256 + hh * 64 + col] = f2bf(keep);
        }
      }
    }
    if (j0 + SCH < T_) commit(Ln);
    __syncthreads();
  }
}

struct AttSmem {
  bf16_t k[64 * 72];
  bf16_t vt[64 * 72];
};

DEV void attn_task(const P& p, int l, int task, AttSmem* sm, const int tid) {
  const int lane = tid & 63, w = tid >> 6, r = lane & 31, h = lane >> 5;
  int b, hq, q0, nkeys;
  if (task < 1024) { b = task >> 6; hq = (task >> 4) & 3; q0 = NC_ + (task & 15) * 128; nkeys = T_; }
  else { int t2 = task - 1024; b = t2 >> 3; hq = (t2 >> 1) & 3; q0 = (t2 & 1) * 128; nkeys = NC_; }
  const int kvh = hq >> 1;
  const bf16_t* ATQ = (const bf16_t*)((const char*)p.out + OUT_ATQ);
  const bf16_t* ATK = (const bf16_t*)((const char*)p.out + OUT_ATK);
  bf16_t* ATO = (bf16_t*)((char*)p.out + OUT_ATO);
  const bf16_t* ZD = (const bf16_t*)(p.ws + OFF_ZD);
  const size_t qrow = (size_t)b * T_ + q0 + 32 * w + r;
  bf16x8 qf[4];
#pragma unroll
  for (int ks = 0; ks < 4; ++ks) qf[ks] = *(const bf16x8*)(ATQ + qrow * 256 + hq * 64 + 16 * ks + 8 * h);
  f32x16 O[2];
#pragma unroll
  for (int e = 0; e < 16; ++e) { O[0][e] = 0.f; O[1][e] = 0.f; }
  float m = -1e30f, lsum = 0.f;
  u4v kreg0, kreg1, vreg0, vreg1;
  auto kv_issue = [&](int kt) __attribute__((always_inline)) {
    const int q0 = tid, q1 = tid + 256;
    kreg0 = *(const u4v*)(ATK + ((size_t)b * T_ + kt + (q0 >> 3)) * 128 + kvh * 64 + 8 * (q0 & 7));
    kreg1 = *(const u4v*)(ATK + ((size_t)b * T_ + kt + (q1 >> 3)) * 128 + kvh * 64 + 8 * (q1 & 7));
    vreg0 = *(const u4v*)(ZD + ((size_t)b * T_ + kt + (q0 & 63)) * 512 + 384 + kvh * 64 + 8 * (q0 >> 6));
    vreg1 = *(const u4v*)(ZD + ((size_t)b * T_ + kt + (q1 & 63)) * 512 + 384 + kvh * 64 + 8 * (q1 >> 6));
  };
  auto v_scatter = [&](const u4v& vv, int q) __attribute__((always_inline)) {
    const int vkey = q & 63, vdc = q >> 6;
    bf16_t* dst = &sm->vt[(8 * vdc) * 72 + vkey];
    dst[0 * 72] = (bf16_t)(vv.x & 0xFFFFu); dst[1 * 72] = (bf16_t)(vv.x >> 16);
    dst[2 * 72] = (bf16_t)(vv.y & 0xFFFFu); dst[3 * 72] = (bf16_t)(vv.y >> 16);
    dst[4 * 72] = (bf16_t)(vv.z & 0xFFFFu); dst[5 * 72] = (bf16_t)(vv.z >> 16);
    dst[6 * 72] = (bf16_t)(vv.w & 0xFFFFu); dst[7 * 72] = (bf16_t)(vv.w >> 16);
  };
  kv_issue(0);
  for (int kt = 0; kt < nkeys; kt += 64) {
    __syncthreads();
    {
      const int q0 = tid, q1 = tid + 256;
      *(u4v*)&sm->k[(q0 >> 3) * 72 + 8 * (q0 & 7)] = kreg0;
      *(u4v*)&sm->k[(q1 >> 3) * 72 + 8 * (q1 & 7)] = kreg1;
      v_scatter(vreg0, q0);
      v_scatter(vreg1, q1);
    }
    __syncthreads();
    if (kt + 64 < nkeys) kv_issue(kt + 64);
    f32x16 Sx[2];
#pragma unroll
    for (int kb = 0; kb < 2; ++kb) {
#pragma unroll
      for (int e = 0; e < 16; ++e) Sx[kb][e] = 0.f;
#pragma unroll
      for (int ks = 0; ks < 4; ++ks) {
        bf16x8 kf = *(const bf16x8*)&sm->k[(32 * kb + r) * 72 + 16 * ks + 8 * h];
        Sx[kb] = __builtin_amdgcn_mfma_f32_32x32x16_bf16(kf, qf[ks], Sx[kb], 0, 0, 0);
      }
    }
    float mx = -1e30f;
#pragma unroll
    for (int kb = 0; kb < 2; ++kb)
#pragma unroll
      for (int e = 0; e < 16; ++e) mx = fmaxf(mx, Sx[kb][e]);
    mx = fmaxf(mx, __shfl_xor(mx, 32, 64));
    const float mnew = fmaxf(m, mx);
    const float scale = __expf(m - mnew);
    m = mnew;
    float ps = 0.f;
#pragma unroll
    for (int kb = 0; kb < 2; ++kb)
#pragma unroll
      for (int e = 0; e < 16; ++e) {
        float pv = __expf(Sx[kb][e] - mnew);
        Sx[kb][e] = pv;
        ps += pv;
      }
    lsum = lsum * scale + ps;
#pragma unroll
    for (int e = 0; e < 16; ++e) { O[0][e] *= scale; O[1][e] *= scale; }
#pragma unroll
    for (int kb = 0; kb < 2; ++kb)
#pragma unroll
      for (int s = 0; s < 2; ++s) {
        bf16x8 pfrag;
#pragma unroll
        for (int j = 0; j < 8; ++j) pfrag[j] = (short)f2bf(Sx[kb][8 * s + j]);
#pragma unroll
        for (int dt = 0; dt < 2; ++dt) {
          const bf16_t* vp = &sm->vt[(32 * dt + r) * 72 + 32 * kb + 16 * s + 4 * h];
          uint2 lo = *(const uint2*)vp, hi = *(const uint2*)(vp + 8);
          bf16x8 vf;
          uint4 tmp; tmp.x = lo.x; tmp.y = lo.y; tmp.z = hi.x; tmp.w = hi.y;
          vf = *(bf16x8*)&tmp;
          O[dt] = __builtin_amdgcn_mfma_f32_32x32x16_bf16(vf, pfrag, O[dt], 0, 0, 0);
        }
      }
  }
  const float ltot = lsum + __shfl_xor(lsum, 32, 64);
  const float invl = 1.f / ltot;
#pragma unroll
  for (int dt = 0; dt < 2; ++dt)
#pragma unroll
    for (int g = 0; g < 4; ++g) {
      uint2 v;
      v.x = pack2(O[dt][4 * g] * invl, O[dt][4 * g + 1] * invl);
      v.y = pack2(O[dt][4 * g + 2] * invl, O[dt][4 * g + 3] * invl);
      *(uint2*)(ATO + qrow * 256 + hq * 64 + 32 * dt + 8 * g + 4 * h) = v;
    }
}

DEV unsigned cu_key() {
  unsigned hw = __builtin_amdgcn_s_getreg((31 << 11) | (0 << 6) | 4);
  unsigned xcc = __builtin_amdgcn_s_getreg((3 << 11) | (0 << 6) | 20) & 0xFu;
  unsigned cu = (hw >> 8) & 0xFu, sh = (hw >> 12) & 1u, se = (hw >> 13) & 7u;
  return (xcc << 8) | (se << 5) | (sh << 4) | cu;
}

DEV void phase_scan(const P& p, int l, char* smem, int rep) {
  const int tid = opaque_tid();
  int* sch = (int*)(p.ws + OFF_SCH) + (l + 2 * rep) * 8448;
  int* cu_cnt = sch;
  int* cu_rank = sch + 4096;
  int* misc = sch + 8192;
  int* sh = (int*)(smem + SMEM_BYTES - 16);
  __syncthreads();
  if (tid == 0) {
    const unsigned key = cu_key();
    const int slot = atomicAdd(&cu_cnt[key], 1);
    int rank;
    if (slot == 0) {
      rank = atomicAdd(&misc[0], 1);
      atomicExch(&cu_rank[key], rank + 1);
    } else {
      while ((rank = atomicAdd(&cu_rank[key], 0)) == 0) __builtin_amdgcn_s_sleep(2);
      rank -= 1;
    }
    sh[1] = (rank < 256) ? (slot == 0 ? 0 : 1) : 2;
  }
  __syncthreads();
  const int role = sh[1];
  const int nA = (l == 0) ? 1152 : 1024;
  for (int stage = 0; stage < 3; ++stage) {
    int qsel;
    if (role == 0) qsel = (stage == 0) ? 0 : (stage == 1 ? 1 : 2);
    else qsel = (stage == 0) ? 1 : (stage == 1 ? 2 : 0);
    const int qn = (qsel == 0) ? 256 : (qsel == 1 ? 256 : nA);
    for (;;) {
      __syncthreads();
      if (tid == 0) sh[0] = atomicAdd(&misc[1 + qsel], 1);
      __syncthreads();
      const int t = sh[0];
      if (t >= qn) break;
      if (qsel == 0) scan_block<0, 8>(p, l, t, (float*)smem, tid);
      else if (qsel == 1) {
        if (t < 128) scan_block<1, 4>(p, l, t, (float*)smem, tid);
        else scan_block<2, 4>(p, l, t - 128, (float*)smem, tid);
      } else attn_task(p, l, t, (AttSmem*)smem, tid);
    }
  }
}

DEV void phase_post(const P& p, int l, char* smem) {
  const int tid = opaque_tid();
  const bf16_t* Y0 = (const bf16_t*)(p.ws + OFF_Y0);
  const bf16_t* Y1 = (const bf16_t*)((const char*)p.out + OUT_Y1);
  const bf16_t* Y2 = (const bf16_t*)((const char*)p.out + OUT_Y2);
  const bf16_t* ATO = (const bf16_t*)((const char*)p.out + OUT_ATO);
  const bf16_t* ZB = (const bf16_t*)(p.ws + OFF_ZB);
  const bf16_t* ZC = (const bf16_t*)(p.ws + OFF_ZC);
  const bf16_t* RWG = (const bf16_t*)(p.ws + OFF_RWG);
  const bf16_t* RWBG = RWG + RWSZ;
  bf16_t* BR = (bf16_t*)(p.ws + OFF_BR);
  const int nm = n_mrows(l);
  {
    const int lane = tid & 63, wv = tid >> 6, c8 = (lane & 31) * 8;
    float ga[8], gb[8];
#pragma unroll
    for (int j = 0; j < 8; ++j) { ga[j] = 1.f; gb[j] = 0.f; }
    if (wv == 0) { ld8f(p.in[16] + l * 256 + c8, ga); ld8f(p.in[17] + l * 256 + c8, gb); }
    else if (wv == 1) { ld8f(p.in[19] + l * 256 + c8, ga); ld8f(p.in[20] + l * 256 + c8, gb); }
    else if (wv == 2) { ld8f(p.in[22] + l * 256 + c8, ga); }
    const bf16_t* Ysrc = (wv == 0) ? Y0 : (wv == 1 ? Y1 : Y2);
#pragma unroll 2
    for (int pr = blockIdx.x; pr < nm / 2; pr += gridDim.x) {
      const int mrow = 2 * pr + (lane >> 5);
      const size_t row = map_row(l, mrow);
      uint4 outv;
      if (wv == 3) {
        outv = *(const uint4*)(ATO + row * 256 + c8);
      } else {
        float y0[8], y1[8], y[8], o[8];
        unpack8(*(const uint4*)(Ysrc + row * 256 + c8), y0);
        unpack8(*(const uint4*)(Ysrc + RWSZ + row * 256 + c8), y1);
        float sm = 0.f, sq = 0.f;
#pragma unroll
        for (int j = 0; j < 8; ++j) { y[j] = y0[j] + y1[j]; sm += y[j]; sq += y[j] * y[j]; }
        if (wv == 2) {
          const float ms = reduce8(sq) * (1.f / 64.f);
          const float rn = rsqrtf(ms + 1e-6f);
          float g[8];
          unpack8(*(const uint4*)(ZC + row * 1280 + 1024 + c8), g);
#pragma unroll
          for (int j = 0; j < 8; ++j) o[j] = y[j] * rn * ga[j] * siluf_(g[j]);
        } else {
          const float mean = reduce8(sm) * (1.f / 64.f);
          float vs = 0.f;
#pragma unroll
          for (int j = 0; j < 8; ++j) { y[j] -= mean; vs += y[j] * y[j]; }
          const float var = reduce8(vs) * (1.f / 64.f);
          const float rn = rsqrtf(var + (wv == 0 ? 64e-5f : 1e-5f));
          if (wv == 0) {
            float g[8], bg[8];
            unpack8(*(const uint4*)(RWG + row * 256 + c8), g);
            unpack8(*(const uint4*)(RWBG + row * 256 + c8), bg);
#pragma unroll
            for (int j = 0; j < 8; ++j) o[j] = (y[j] * rn * ga[j] + gb[j]) * g[j] + bg[j];
          } else {
            float g[8];
            unpack8(*(const uint4*)(ZB + row * 1024 + 768 + c8), g);
#pragma unroll
            for (int j = 0; j < 8; ++j) o[j] = (y[j] * rn * ga[j] + gb[j]) * siluf_(g[j]);
          }
        }
        outv = pack8(o);
      }
      *(uint4*)(BR + (size_t)mrow * 1024 + wv * 256 + c8) = outv;
    }
  }
  {
    const int n = tid * 4;
#pragma unroll 2
    for (int mrow = blockIdx.x; mrow < nm; mrow += gridDim.x) {
      const int row = map_row(l, mrow);
      const float4 x = *(const float4*)(xin_row(p, l, row) + n);
      const float* mr = mod_row(p, l, row);
      const float4 sh = *(const float4*)(mr + n), sc = *(const float4*)(mr + 1024 + n);
      uint2 o;
      o.x = pack2(x.x * (1.f + sc.x) + sh.x, x.y * (1.f + sc.y) + sh.y);
      o.y = pack2(x.z * (1.f + sc.z) + sh.z, x.w * (1.f + sc.w) + sh.w);
      *(uint2*)(u2_row(p, row) + n) = o;
    }
  }
  conv_batch(p.in[25] + (size_t)l * 4 * 1024 * 1024, (bf16_t*)(p.ws + OFF_WGT), 1024, 1024, 4, (float*)smem, tid);
  conv_batch(p.in[26] + (size_t)l * 4 * 256 * 1024, (bf16_t*)(p.ws + OFF_WBT), 256, 1024, 4, (float*)smem, tid);
  conv_batch(p.in[27] + (size_t)l * 1024 * 1024, (bf16_t*)(p.ws + OFF_WOT), 1024, 1024, 1, (float*)smem, tid);
}

DEV void phase_merge(const P& p, int l, char* smem) {
  GemmSmem* sm = (GemmSmem*)smem;
  ACC_IDS
  {
    int* tc = (int*)(p.ws + OFF_TCNT);
    for (int i = blockIdx.x * 256 + tid; i < ROWS_; i += gridDim.x * 256) tc[i] = 0;
  }
  const bf16_t* BR = (const bf16_t*)(p.ws + OFF_BR);
  bf16_t* MRG = (bf16_t*)(p.ws + OFF_MRG);
  int mt, nt;
  unsigned* lds32 = (unsigned*)smem;
  for (int it = 0; tile_map(it, n_mrows(l) / 128, 8, mt, nt); ++it) {
    f32x16 mer[2][2];
#pragma unroll
    for (int mi = 0; mi < 2; ++mi)
#pragma unroll
      for (int ni = 0; ni < 2; ++ni)
#pragma unroll
        for (int e = 0; e < 16; ++e) mer[mi][ni][e] = 0.f;
    ALBf au, ab;
#pragma unroll
    for (int q = 0; q < 2; ++q) {
      const int mrow = mt * 128 + (tid >> 2) + 64 * q;
      au.ap[q] = u2_row(p, map_row(l, mrow));
      ab.ap[q] = BR + (size_t)mrow * 1024;
    }
    for (int i = 0; i < 4; ++i) {
      {
        f32x16 abr[1][2][2];
        acc_zero<1, 2>(abr);
        ALBf abi = ab;
        abi.ap[0] += i * 256;
        abi.ap[1] += i * 256;
        gemm_core<1, 2>(abi, (const bf16_t*)(p.ws + OFF_WBT) + ((size_t)(i * 1024 + nt * 128)) * 256, nullptr, 256, 256, sm, abr, tid);
#pragma unroll
        for (int mi = 0; mi < 2; ++mi)
#pragma unroll
          for (int ni = 0; ni < 2; ++ni)
#pragma unroll
            for (int e = 0; e < 8; ++e) {
              const int j = (mi * 2 + ni) * 8 + e;
              const int word = (j < 10) ? (7680 + j * 256) : (j < 20 ? (12800 + (j - 10) * 256) : (15360 + (j - 20) * 256));
              lds32[word + tid] = pack2(abr[0][mi][ni][2 * e], abr[0][mi][ni][2 * e + 1]);
            }
      }
      f32x16 ag[1][2][2];
      acc_zero<1, 2>(ag);
      gemm_core<1, 2>(au, (const bf16_t*)(p.ws + OFF_WGT) + ((size_t)(i * 1024 + nt * 128)) * 1024, nullptr, 1024, 1024, sm, ag, tid);
#pragma unroll
      for (int mi = 0; mi < 2; ++mi)
#pragma unroll
        for (int ni = 0; ni < 2; ++ni)
#pragma unroll
          for (int e = 0; e < 8; ++e) {
            const int j = (mi * 2 + ni) * 8 + e;
            const int word = (j < 10) ? (7680 + j * 256) : (j < 20 ? (12800 + (j - 10) * 256) : (15360 + (j - 20) * 256));
            const unsigned bp = lds32[word + tid];
            mer[mi][ni][2 * e] += sigmoidf_(ag[0][mi][ni][2 * e]) * __uint_as_float(bp << 16);
            mer[mi][ni][2 * e + 1] += sigmoidf_(ag[0][mi][ni][2 * e + 1]) * __uint_as_float(bp & 0xFFFF0000u);
          }
    }
#pragma unroll
    for (int mi = 0; mi < 2; ++mi)
#pragma unroll
      for (int ni = 0; ni < 2; ++ni)
#pragma unroll
        for (int e = 0; e < 16; e += 2)
          store_rowpair_bf16(MRG, 1024, mt * 128 + ACC_ROW(mi, e), nt * 128 + ACC_COL(ni), mer[mi][ni][e], mer[mi][ni][e + 1]);
  }
}

DEV void phase_out(const P& p, int l, char* smem) {
  GemmSmem* sm = (GemmSmem*)smem;
  ACC_IDS
  const bf16_t* MRG = (const bf16_t*)(p.ws + OFF_MRG);
  float* XA = (float*)(p.ws + OFF_XA);
  int mt, nt;
  for (int it = 0; tile_map(it, n_mrows(l) / 128, 8, mt, nt); ++it) {
    const bf16_t* apm[4];
#pragma unroll
    for (int q = 0; q < 4; ++q) apm[q] = MRG + (size_t)(mt * 128 + (tid >> 3) + 32 * q) * 1024;
    f32x16 acc[1][2][2];
    acc_zero<1, 2>(acc);
    gemm64<2>(apm, (const bf16_t*)(p.ws + OFF_WOT) + (size_t)(nt * 128) * 1024, 1024, 1024, (GemmSmem64*)smem, acc, tid);
#pragma unroll
    for (int mi = 0; mi < 2; ++mi)
#pragma unroll
      for (int e = 0; e < 16; ++e) {
        const int mrow = mt * 128 + ACC_ROW(mi, e);
        const int row = map_row(l, mrow);
        const float* xr = xin_row(p, l, row);
        const float* mr = mod_row(p, l, row);
#pragma unroll
        for (int ni = 0; ni < 2; ++ni) {
          int col = nt * 128 + ACC_COL(ni);
          XA[(size_t)row * D_ + col] = ALPHA * xr[col] + mr[2048 + col] * acc[0][mi][ni][e];
        }
      }
  }
}

DEV float block_sum(float v, float* red, const int tid) {
  v = wave_sum(v);
  __syncthreads();
  if ((tid & 63) == 0) red[tid >> 6] = v;
  __syncthreads();
  return (red[0] + red[1]) + (red[2] + red[3]);
}

DEV void phase_ln1(const P& p, int l, char* smem) {
  float* u2s = (float*)smem;
  float* part = u2s + 4096;
  const int tid = opaque_tid(), lane = tid & 63, wv = tid >> 6;
  float* XA = (float*)(p.ws + OFF_XA);
  float* AFF = (float*)(p.ws + OFF_AFF);
  const float* lng = p.in[28] + l * 1024;
  const float* lnb = p.in[29] + l * 1024;
  const int re = tid & 15, ng = tid >> 4;
  float wr[64];
  {
    const float* WR = p.in[30] + (size_t)l * 1024 * 16;
#pragma unroll
    for (int j = 0; j < 64; ++j) wr[j] = WR[(size_t)(ng * 64 + j) * 16 + re];
  }
  const int nm = n_mrows(l);
  for (int grp = blockIdx.x; grp < nm / 4; grp += gridDim.x) {
    const int mrow = grp * 4 + wv;
    const int row = map_row(l, mrow);
    const float* mr = mod_row(p, l, row);
    float4 v[4];
    float sm = 0.f;
#pragma unroll
    for (int i = 0; i < 4; ++i) {
      v[i] = *(const float4*)(XA + (size_t)row * D_ + 4 * lane + 256 * i);
      sm += (v[i].x + v[i].y) + (v[i].z + v[i].w);
    }
    const float mean = wave_sum(sm) * (1.f / 1024.f);
    float vs = 0.f;
#pragma unroll
    for (int i = 0; i < 4; ++i) {
      v[i].x -= mean; v[i].y -= mean; v[i].z -= mean; v[i].w -= mean;
      vs += (v[i].x * v[i].x + v[i].y * v[i].y) + (v[i].z * v[i].z + v[i].w * v[i].w);
    }
    const float rs = rsqrtf(wave_sum(vs) * (1.f / 1024.f) + 1e-5f);
#pragma unroll
    for (int i = 0; i < 4; ++i) {
      const int n = 4 * lane + 256 * i;
      const float4 gq = *(const float4*)(lng + n), bq = *(const float4*)(lnb + n);
      const float4 x1 = make_float4(v[i].x * rs * gq.x + bq.x, v[i].y * rs * gq.y + bq.y,
                                    v[i].z * rs * gq.z + bq.z, v[i].w * rs * gq.w + bq.w);
      *(float4*)(XA + (size_t)row * D_ + n) = x1;
      const float4 sh = *(const float4*)(mr + 3072 + n), scv = *(const float4*)(mr + 4096 + n);
      const float4 um = make_float4(x1.x * (1.f + scv.x) + sh.x, x1.y * (1.f + scv.y) + sh.y,
                                    x1.z * (1.f + scv.z) + sh.z, x1.w * (1.f + scv.w) + sh.w);
      *(float4*)(u2s + wv * 1024 + n) = um;
      uint2 ub;
      ub.x = pack2(um.x, um.y);
      ub.y = pack2(um.z, um.w);
      *(uint2*)((bf16_t*)(p.ws + OFF_XS) + (size_t)row * D_ + n) = ub;
    }
    __syncthreads();
    float acc[4] = {0.f, 0.f, 0.f, 0.f};
#pragma unroll
    for (int j4 = 0; j4 < 16; ++j4) {
#pragma unroll
      for (int rw = 0; rw < 4; ++rw) {
        const float4 u = *(const float4*)(u2s + rw * 1024 + ng * 64 + 4 * j4);
        acc[rw] += u.x * wr[4 * j4] + u.y * wr[4 * j4 + 1] + u.z * wr[4 * j4 + 2] + u.w * wr[4 * j4 + 3];
      }
    }
#pragma unroll
    for (int rw = 0; rw < 4; ++rw) part[(ng * 4 + rw) * 16 + re] = acc[rw];
    __syncthreads();
    if (tid < 64) {
      const int rw = tid >> 4;
      float lg = 0.f;
#pragma unroll
      for (int g = 0; g < 16; ++g) lg += part[(g * 4 + rw) * 16 + re];
      float mx = lg;
#pragma unroll
      for (int o = 8; o > 0; o >>= 1) mx = fmaxf(mx, __shfl_xor(mx, o, 16));
      const float ex = __expf(lg - mx);
      const float den = reduce16(ex);
      const int r2 = map_row(l, grp * 4 + rw);
      const int b = r2 / T_, t = r2 - b * T_;
      AFF[((size_t)(b * 16 + re)) * T_ + t] = ex / den;
    }
  }
  conv_batch(p.in[31] + (size_t)l * 16 * 1024 * 1024, (bf16_t*)(p.ws + OFF_WE1T), 1024, 1024, 16, (float*)smem, tid);
  conv_batch(p.in[32] + (size_t)l * 16 * 1024 * 1024, (bf16_t*)(p.ws + OFF_WE3T), 1024, 1024, 16, (float*)smem, tid);
  conv_batch(p.in[33] + (size_t)l * 16 * 1024 * 1024, (bf16_t*)(p.ws + OFF_WE2T), 1024, 1024, 16, (float*)smem, tid);
}

DEV void phase_topk(const P& p, int l, char* smem) {
  u64* keys = (u64*)smem;
  const int tid = opaque_tid();
  const float* AFF = (const float*)(p.ws + OFF_AFF);
  int* IDX = (int*)(p.ws + OFF_IDX);
  float* GATE = (float*)(p.ws + OFF_GATE);
  const int ntask = (l == 0) ? 512 : 256;
  for (int task = blockIdx.x; task < ntask; task += gridDim.x) {
    const int seg = task >> 8, be = task & 255;
    const int n = seg ? NC_ : NL_, t0 = seg ? 0 : NC_, cap = seg ? 32 : 256;
    const float* aff = AFF + (size_t)be * T_ + t0;
    __syncthreads();
    for (int i = tid; i < 2048; i += 256)
      keys[i] = (i < n) ? (((u64)__float_as_uint(aff[i]) << 32) | (u64)(0xFFFFFFFFu - (unsigned)i)) : 0ull;
    __syncthreads();
    for (int k = 2; k <= 2048; k <<= 1)
      for (int j = k >> 1; j > 0; j >>= 1) {
        for (int i = tid; i < 2048; i += 256) {
          int ixj = i ^ j;
          if (ixj > i) {
            u64 a = keys[i], bb = keys[ixj];
            bool desc = ((i & k) == 0);
            if (desc ? (a < bb) : (a > bb)) { keys[i] = bb; keys[ixj] = a; }
          }
        }
        __syncthreads();
      }
    for (int i = tid; i < cap; i += 256) {
      u64 kv = keys[i];
      IDX[be * 288 + seg * 256 + i] = (int)(0xFFFFFFFFu - (unsigned)(kv & 0xFFFFFFFFull));
      GATE[be * 288 + seg * 256 + i] = __uint_as_float((unsigned)(kv >> 32));
      {
        const int bb = be >> 4, ee = be & 15;
        const int tok = (int)(0xFFFFFFFFu - (unsigned)(kv & 0xFFFFFFFFull));
        const int grow = bb * T_ + t0 + tok;
        const int slot = seg ? (bb * 32 + i) : (bb * 256 + i);
        const int yrow = (ee * 36 + (seg ? 32 : 0) + (slot >> 7)) * 128 + (slot & 127);
        const int pos = atomicAdd((int*)(p.ws + OFF_TCNT) + grow, 1);
        uint2 ent;
        ent.x = (unsigned)yrow;
        ent.y = (unsigned)(kv >> 32);
        ((uint2*)(p.ws + OFF_TLIST))[(size_t)grow * 16 + (pos & 15)] = ent;
      }
    }
  }
}

DEV void slot_info(const P& p, int e, int mtile, int rr, int& row, float& gate, int& seg, int& b, int& idx) {
  const int* IDX = (const int*)(p.ws + OFF_IDX);
  const float* GATE = (const float*)(p.ws + OFF_GATE);
  if (mtile < 32) {
    int slot = mtile * 128 + rr;
    b = slot >> 8;
    int j = slot & 255;
    idx = IDX[(b * 16 + e) * 288 + j];
    gate = GATE[(b * 16 + e) * 288 + j];
    seg = 0;
    row = b * T_ + NC_ + idx;
  } else {
    int slot = (mtile - 32) * 128 + rr;
    b = slot >> 5;
    int j = slot & 31;
    idx = IDX[(b * 16 + e) * 288 + 256 + j];
    gate = GATE[(b * 16 + e) * 288 + 256 + j];
    seg = 1;
    row = b * T_ + idx;
  }
}

DEV void phase_eup(const P& p, int l, char* smem) {
  GemmSmem* sm = (GemmSmem*)smem;
  ACC_IDS
  const float* XA = (const float*)(p.ws + OFF_XA);
  bf16_t* H = (bf16_t*)(p.ws + OFF_H);
  const int MT = (l == 0) ? 36 : 32;
  int em, nt;
  for (int it = 0; tile_map(it, 16 * MT, 8, em, nt); ++it) {
    const int mt = em % MT, e = em / MT;
    ALBfIdx al;
    al.base = (const bf16_t*)(p.ws + OFF_XS);
#pragma unroll
    for (int q = 0; q < 2; ++q) {
      int row, seg, b, idx;
      float gate;
      slot_info(p, e, mt, (tid >> 2) + 64 * q, row, gate, seg, b, idx);
      al.off[q] = (unsigned)row * (unsigned)D_;
    }
    f32x16 acc[2][2][2];
    acc_zero<2, 2>(acc);
    const size_t wo = ((size_t)(e * 1024 + nt * 128)) * 1024;
    gemm_core<2, 2>(al, (const bf16_t*)(p.ws + OFF_WE1T) + wo, (const bf16_t*)(p.ws + OFF_WE3T) + wo, 1024, 1024, sm, acc, tid);
#pragma unroll
    for (int mi = 0; mi < 2; ++mi)
#pragma unroll
      for (int ni = 0; ni < 2; ++ni)
#pragma unroll
        for (int q = 0; q < 16; q += 2)
          store_rowpair_bf16(H, 1024, (e * 36 + mt) * 128 + ACC_ROW(mi, q), nt * 128 + ACC_COL(ni),
                             siluf_(acc[0][mi][ni][q]) * acc[1][mi][ni][q], siluf_(acc[0][mi][ni][q + 1]) * acc[1][mi][ni][q + 1]);
  }
}

DEV void phase_edown(const P& p, int l, char* smem) {
  ACC_IDS
  const bf16_t* H = (const bf16_t*)(p.ws + OFF_H);
  bf16_t* YE = (bf16_t*)(p.ws + OFF_YEXP);
  const int MT = (l == 0) ? 36 : 32;
  int em, nt;
  for (int it = 0; tile_map(it, 16 * MT, 8, em, nt); ++it) {
    const int mt = em % MT, e = em / MT;
    const bf16_t* aph[4];
#pragma unroll
    for (int q = 0; q < 4; ++q) aph[q] = H + (size_t)((e * 36 + mt) * 128 + (tid >> 3) + 32 * q) * 1024;
    f32x16 acc[1][2][2];
    acc_zero<1, 2>(acc);
    gemm64<2>(aph, (const bf16_t*)(p.ws + OFF_WE2T) + ((size_t)(e * 1024 + nt * 128)) * 1024, 1024, 1024, (GemmSmem64*)smem, acc, tid);
#pragma unroll
    for (int mi = 0; mi < 2; ++mi)
#pragma unroll
      for (int ni = 0; ni < 2; ++ni)
#pragma unroll
        for (int q = 0; q < 16; q += 2)
          store_rowpair_bf16(YE, 1024, (e * 36 + mt) * 128 + ACC_ROW(mi, q), nt * 128 + ACC_COL(ni), acc[0][mi][ni][q], acc[0][mi][ni][q + 1]);
  }
}

DEV void phase_ln2(const P& p, int l, char* smem) {
  const int tid = opaque_tid(), lane = tid & 63, wv = tid >> 6;
  float* XA = (float*)(p.ws + OFF_XA);
  const bf16_t* YE = (const bf16_t*)(p.ws + OFF_YEXP);
  const int* TC = (const int*)(p.ws + OFF_TCNT);
  const uint2* TL = (const uint2*)(p.ws + OFF_TLIST);
  float4 g4[4], b4[4];
#pragma unroll
  for (int i = 0; i < 4; ++i) {
    g4[i] = *(const float4*)(p.in[34] + l * 1024 + 4 * lane + 256 * i);
    b4[i] = *(const float4*)(p.in[35] + l * 1024 + 4 * lane + 256 * i);
  }
  const int nm = n_mrows(l);
  for (int mrow = blockIdx.x * 4 + wv; mrow < nm; mrow += gridDim.x * 4) {
    const int row = map_row(l, mrow);
    const int b = row / T_, t = row - b * T_;
    const float* mr = mod_row(p, l, row);
    float4 f[4];
#pragma unroll
    for (int i = 0; i < 4; ++i) f[i] = make_float4(0.f, 0.f, 0.f, 0.f);
    const int nc = min(TC[row], 16);
    uint2 ent4[4];
#pragma unroll
    for (int k = 0; k < 4; ++k) ent4[k] = TL[(size_t)row * 16 + k];
    auto add_contrib = [&](const uint2 ent) __attribute__((always_inline)) {
      const float gate = __uint_as_float(ent.y);
      const bf16_t* yr = YE + (size_t)ent.x * 1024;
#pragma unroll
      for (int i = 0; i < 4; ++i) {
        const uint2 yv = *(const uint2*)(yr + 4 * lane + 256 * i);
        f[i].x += gate * __uint_as_float(yv.x << 16);
        f[i].y += gate * __uint_as_float(yv.x & 0xFFFF0000u);
        f[i].z += gate * __uint_as_float(yv.y << 16);
        f[i].w += gate * __uint_as_float(yv.y & 0xFFFF0000u);
      }
    };
#pragma unroll
    for (int k = 0; k < 4; ++k)
      if (k < nc) add_contrib(ent4[k]);
    for (int k = 4; k < nc; ++k) add_contrib(TL[(size_t)row * 16 + k]);
    float4 v[4];
    float sm = 0.f;
#pragma unroll
    for (int i = 0; i < 4; ++i) {
      const int n = 4 * lane + 256 * i;
      const float4 x1 = *(const float4*)(XA + (size_t)row * D_ + n);
      const float4 g2 = *(const float4*)(mr + 5120 + n);
      v[i] = make_float4(ALPHA * x1.x + g2.x * f[i].x, ALPHA * x1.y + g2.y * f[i].y, ALPHA * x1.z + g2.z * f[i].z,
                         ALPHA * x1.w + g2.w * f[i].w);
      sm += (v[i].x + v[i].y) + (v[i].z + v[i].w);
    }
    const float mean = wave_sum(sm) * (1.f / 1024.f);
    float vs = 0.f;
#pragma unroll
    for (int i = 0; i < 4; ++i) {
      v[i].x -= mean; v[i].y -= mean; v[i].z -= mean; v[i].w -= mean;
      vs += (v[i].x * v[i].x + v[i].y * v[i].y) + (v[i].z * v[i].z + v[i].w * v[i].w);
    }
    const float rs = rsqrtf(wave_sum(vs) * (1.f / 1024.f) + 1e-5f);
    float* orow = p.out + ((size_t)(b * NL_ + t - NC_)) * D_;
#pragma unroll
    for (int i = 0; i < 4; ++i) {
      const int n = 4 * lane + 256 * i;
      const float4 o = make_float4(v[i].x * rs * g4[i].x + b4[i].x, v[i].y * rs * g4[i].y + b4[i].y,
                                   v[i].z * rs * g4[i].z + b4[i].z, v[i].w * rs * g4[i].w + b4[i].w);
      if (l == 0) {
        *(float4*)(XA + (size_t)row * D_ + n) = o;
        write_u_row(p, 1, row, o, n);
      } else *(float4*)(orow + n) = o;
    }
  }
  if (l == 0) conv_batch(p.in[6] + (size_t)1024 * 3968, (bf16_t*)(p.ws + OFF_WINT1), 1024, 3968, 1, (float*)smem, tid);
}

constexpr int NPHASE = 23;
DEV void run_phase(const P& p, int ph, char* smem) {
  if (ph == 0) { phase_mod(p, smem); return; }
  const int l = (ph - 1) / 11, k = (ph - 1) % 11;
  switch (k) {
    case 0: phase_in(p, l, smem); break;
    case 1: phase_prep(p, l, smem); break;
    case 2: phase_scan(p, l, smem, 0); break;
    case 3: phase_post(p, l, smem); break;
    case 4: phase_merge(p, l, smem); break;
    case 5: phase_out(p, l, smem); break;
    case 6: phase_ln1(p, l, smem); break;
    case 7: phase_topk(p, l, smem); break;
    case 8: phase_eup(p, l, smem); break;
    case 9: phase_edown(p, l, smem); break;
    default: phase_ln2(p, l, smem); break;
  }
}

#define XB_TMO      128
#define XB_XCNT(j)  (256  + 64 * (j))
#define XB_XSUB(j)  (1280 + 64 * (j))
#define XB_XGEN(j)  (2304 + 64 * (j))
#define XB_TOP      3328
#define XB_TOPGEN   3392
#define XCD_BAR_WORDS 3456
#define XB_SPIN_CAP (1u << 22)
#define LAS __attribute__((address_space(3)))
DEV unsigned xb_ld(unsigned* p) { return __hip_atomic_load(p, __ATOMIC_RELAXED, __HIP_MEMORY_SCOPE_AGENT); }
DEV unsigned xb_add(unsigned* p, unsigned v) { return __hip_atomic_fetch_add(p, v, __ATOMIC_RELAXED, __HIP_MEMORY_SCOPE_AGENT); }
DEV unsigned xb_xcc_id() { return (unsigned)__builtin_amdgcn_s_getreg((3 << 11) | 20) & 0xFu; }
#define XB_SPIN(cond, bar) do { unsigned _sp = 0; while (cond) { __builtin_amdgcn_s_sleep(1); \
    if ((++_sp & 255u) == 0u) { if (xb_ld(&(bar)[XB_TMO])) break; if (_sp > XB_SPIN_CAP) { atomicAdd(&(bar)[XB_TMO], 1u); break; } } } } while (0)
struct XcdBarrier {
  unsigned* bar;
  unsigned x;
  volatile LAS unsigned* st;
};
DEV XcdBarrier xcd_barrier_post(unsigned* bar, volatile LAS unsigned* st) {
  XcdBarrier b; b.bar = bar; b.x = xb_xcc_id(); b.st = st;
  if (threadIdx.x == 0) (void)xb_add(&bar[XB_XCNT(b.x)], 1u);
  return b;
}
DEV void xcd_barrier_complete(unsigned* bar, unsigned x, unsigned& nloc, unsigned& nx) {
  const unsigned G = gridDim.x * gridDim.y * gridDim.z;
  unsigned sum, cnt, mine, sp = 0u;
  for (;;) {
    sum = 0u; cnt = 0u; mine = 0u;
#pragma unroll
    for (unsigned j = 0; j < 16; ++j) { const unsigned c = xb_ld(&bar[XB_XCNT(j)]); sum += c; cnt += (c > 0u) ? 1u : 0u; mine = (j == x) ? c : mine; }
    if (sum == G) break;
    __builtin_amdgcn_s_sleep(1);
    if ((++sp & 255u) == 0u) { if (xb_ld(&bar[XB_TMO])) break; if (sp > XB_SPIN_CAP) { atomicAdd(&bar[XB_TMO], 1u); break; } }
  }
  nloc = mine > 0u ? mine : 1u; nx = cnt > 0u ? cnt : 1u;
}
DEV void xcd_barrier(const XcdBarrier& b) {
  asm volatile("s_waitcnt vmcnt(0)" ::: "memory");
  __syncthreads();
  if (threadIdx.x == 0) {
    unsigned* bar = b.bar;
    __builtin_amdgcn_s_waitcnt(0);
    unsigned nloc = b.st[0], nx = b.st[1];
    if (nloc == 0u) { xcd_barrier_complete(bar, b.x, nloc, nx); b.st[0] = nloc; b.st[1] = nx; }
    const unsigned old = xb_add(&bar[XB_XSUB(b.x)], 1u);
    const unsigned gen = old / nloc;
    if (old + 1u == (gen + 1u) * nloc) {
      __builtin_amdgcn_fence(__ATOMIC_RELEASE, "agent");
      asm volatile("s_waitcnt vmcnt(0)" ::: "memory");
      const unsigned og = xb_add(&bar[XB_TOP], 1u);
      const unsigned tg = og / nx;
      if (og + 1u == (tg + 1u) * nx) xb_add(&bar[XB_TOPGEN], 1u);
      else XB_SPIN(xb_ld(&bar[XB_TOPGEN]) == tg, bar);
      __builtin_amdgcn_fence(__ATOMIC_ACQUIRE, "agent");
      xb_add(&bar[XB_XGEN(b.x)], 1u);
      asm volatile("s_waitcnt vmcnt(0)" ::: "memory");
    } else {
      XB_SPIN(xb_ld(&bar[XB_XGEN(b.x)]) == gen, bar);
      __builtin_amdgcn_fence(__ATOMIC_ACQUIRE, "agent");
      asm volatile("s_waitcnt vmcnt(0)" ::: "memory");
    }
  }
  __syncthreads();
}

#ifndef REPMASK
#define REPMASK 0
#endif
template <int L>
DEV void run_layer(const P& p, char* smem, const XcdBarrier& xb) {
  phase_in(p, L, smem);
  xcd_barrier(xb);
  if (REPMASK & (1 << 0)) { phase_in(p, L, smem); xcd_barrier(xb); }
  phase_prep(p, L, smem);
  xcd_barrier(xb);
  phase_prep2(p, L, smem);
  xcd_barrier(xb);
  if (REPMASK & (1 << 1)) { phase_prep(p, L, smem); xcd_barrier(xb); phase_prep2(p, L, smem); xcd_barrier(xb); }
  phase_scan(p, L, smem, 0);
  xcd_barrier(xb);
  if (REPMASK & (1 << 2)) { phase_scan(p, L, smem, 1); xcd_barrier(xb); }
  phase_post(p, L, smem);
  xcd_barrier(xb);
  if (REPMASK & (1 << 3)) { phase_post(p, L, smem); xcd_barrier(xb); }
  phase_merge(p, L, smem);
  xcd_barrier(xb);
  if (REPMASK & (1 << 4)) { phase_merge(p, L, smem); xcd_barrier(xb); }
  phase_out(p, L, smem);
  xcd_barrier(xb);
  if (REPMASK & (1 << 5)) { phase_out(p, L, smem); xcd_barrier(xb); }
  phase_ln1(p, L, smem);
  xcd_barrier(xb);
  if (REPMASK & (1 << 6)) { phase_ln1(p, L, smem); xcd_barrier(xb); }
  phase_topk(p, L, smem);
  xcd_barrier(xb);
  if (REPMASK & (1 << 7)) { phase_topk(p, L, smem); xcd_barrier(xb); }
  phase_eup(p, L, smem);
  xcd_barrier(xb);
  if (REPMASK & (1 << 8)) { phase_eup(p, L, smem); xcd_barrier(xb); }
  phase_edown(p, L, smem);
  xcd_barrier(xb);
  if (REPMASK & (1 << 9)) { phase_edown(p, L, smem); xcd_barrier(xb); }
  phase_ln2(p, L, smem);
}

__global__ void __launch_bounds__(256, 2) mega(P p) {
  __shared__ __attribute__((aligned(16))) char smem[SMEM_BYTES];
  __shared__ uint4 xb_words;
  cg::grid_group grid = cg::this_grid();
  if (threadIdx.x == 0) xb_words = make_uint4(0u, 0u, 0u, 0u);
  __syncthreads();
  XcdBarrier xb = xcd_barrier_post((unsigned*)(p.ws + OFF_BAR), (volatile LAS unsigned*)&xb_words);
  phase_mod(p, smem);
  if (p.ws == nullptr) grid.sync();
  xcd_barrier(xb);
  phase_u(p, smem);
  xcd_barrier(xb);
  run_layer<0>(p, smem, xb);
  xcd_barrier(xb);
  run_layer<1>(p, smem, xb);
}

#ifdef MULTI_LAUNCH
template <int K>
__global__ void __launch_bounds__(256) phase_kernel(P p, int l) {
  __shared__ __attribute__((aligned(16))) char smem[SMEM_BYTES];
  if (K == -1) phase_mod(p, smem);
  if (K == 0) phase_in(p, l, smem);
  if (K == 1) phase_prep(p, l, smem);
  if (K == 2) phase_scan(p, l, smem, 0);
  if (K == 3) phase_post(p, l, smem);
  if (K == 4) phase_merge(p, l, smem);
  if (K == 5) phase_out(p, l, smem);
  if (K == 6) phase_ln1(p, l, smem);
  if (K == 7) phase_topk(p, l, smem);
  if (K == 8) phase_eup(p, l, smem);
  if (K == 9) phase_edown(p, l, smem);
  if (K == 10) phase_ln2(p, l, smem);
}
#endif

extern "C" void kernel_launch(void* const* d_in, const int* in_sizes, int n_in, void* d_out, int out_size,
                              void* d_ws, size_t ws_size, hipStream_t stream) {
  static int grid_blocks = 0;
  if (!grid_blocks) {
    int dev = 0, cus = 0, per_cu = 0;
    hipGetDevice(&dev);
    hipDeviceGetAttribute(&cus, hipDeviceAttributeMultiprocessorCount, dev);
    hipOccupancyMaxActiveBlocksPerMultiprocessor(&per_cu, mega, 256, 0);
    if (per_cu > 2) per_cu = 2;
    if (per_cu < 1) per_cu = 1;
    grid_blocks = cus * per_cu;
  }
  P p{};
  for (int i = 0; i < 36; ++i) p.in[i] = (const float*)d_in[i];
  p.out = (float*)d_out;
  p.ws = (char*)d_ws;
  if (ws_size < WS_NEED) fprintf(stderr, "workspace too small: %zu < %zu\n", ws_size, WS_NEED);
#ifdef MULTI_LAUNCH
  const dim3 g(grid_blocks), bk(256);
  hipLaunchKernelGGL(phase_kernel<-1>, g, bk, 0, stream, p, 0);
  for (int l = 0; l < 2; ++l) {
    hipLaunchKernelGGL(phase_kernel<0>, g, bk, 0, stream, p, l);
    hipLaunchKernelGGL(phase_kernel<1>, g, bk, 0, stream, p, l);
    hipLaunchKernelGGL(phase_kernel<2>, g, bk, 0, stream, p, l);
    hipLaunchKernelGGL(phase_kernel<3>, g, bk, 0, stream, p, l);
    hipLaunchKernelGGL(phase_kernel<4>, g, bk, 0, stream, p, l);
    hipLaunchKernelGGL(phase_kernel<5>, g, bk, 0, stream, p, l);
    hipLaunchKernelGGL(phase_kernel<6>, g, bk, 0, stream, p, l);
    hipLaunchKernelGGL(phase_kernel<7>, g, bk, 0, stream, p, l);
    hipLaunchKernelGGL(phase_kernel<8>, g, bk, 0, stream, p, l);
    hipLaunchKernelGGL(phase_kernel<9>, g, bk, 0, stream, p, l);
    hipLaunchKernelGGL(phase_kernel<10>, g, bk, 0, stream, p, l);
  }
#else
  hipMemsetAsync((char*)d_ws + OFF_BAR, 0, XCD_BAR_WORDS * 4, stream);
  void* args[] = {&p};
  hipError_t e = hipLaunchCooperativeKernel((void*)mega, dim3(grid_blocks), dim3(256), args, 0, stream);
  if (e != hipSuccess) fprintf(stderr, "cooperative launch failed: %s (grid %d)\n", hipGetErrorString(e), grid_blocks);
#endif
}
```

```cpp
#include <hip/hip_runtime.h>
#include <hip/hip_cooperative_groups.h>
#include <stdint.h>
#include <stdio.h>
namespace cg = cooperative_groups;

typedef unsigned short bf16_t;
using bf16x8 = __attribute__((ext_vector_type(8))) short;
using f32x16 = __attribute__((ext_vector_type(16))) float;
typedef unsigned long long u64;
#define DEV __device__ __forceinline__

constexpr int NB_ = 16, T_ = 2304, NC_ = 256, NL_ = 2048, D_ = 1024, ROWS_ = NB_ * T_;
constexpr float ALPHA = 1.41421356237309515f;
constexpr size_t MiB = 1ull << 20;
constexpr size_t OFF_MOD = 0, OFF_COS = 1 * MiB, OFF_SIN = 1 * MiB + 262144, OFF_AFF = 2 * MiB,
                 OFF_IDX = 5 * MiB, OFF_GATE = 5 * MiB + 512 * 1024;
constexpr size_t OFF_XA = 6 * MiB, OFF_ZA = 150 * MiB, OFF_ZB = 231 * MiB, OFF_ZC = 303 * MiB, OFF_ZD = 393 * MiB,
                 OFF_RWW = 429 * MiB, OFF_RWA = 501 * MiB, OFF_RWR = 537 * MiB, OFF_RWG = 609 * MiB;
constexpr size_t WS_NEED = 645 * MiB;
constexpr size_t OFF_CNT = 1 * MiB - 256;
constexpr size_t OFF_BAR = 900 * 1024;
constexpr size_t OFF_LW = 1 * MiB + 512 * 1024;
constexpr size_t OFF_SCH = 4 * MiB + 512 * 1024;
constexpr size_t OFF_WINT = OFF_RWW;
constexpr size_t OFF_WGT = OFF_ZA + 40 * MiB;
constexpr size_t OFF_WBT = OFF_WGT + 8 * MiB;
constexpr size_t OFF_WOT = OFF_WBT + 2 * MiB;
constexpr size_t OFF_U = OFF_RWR;
constexpr size_t OFF_TCNT = OFF_RWG;
constexpr size_t OFF_TLIST = OFF_RWG + 1 * MiB;
constexpr size_t OFF_WINT1 = 480 * MiB;
constexpr size_t OFF_YEXP = 335 * MiB;
constexpr size_t OFF_XS = 400 * MiB;
constexpr size_t OFF_WE2T = OFF_ZC, OFF_WE1T = OFF_ZC + 32 * MiB, OFF_WE3T = OFF_ZC + 64 * MiB;
constexpr int SMEM_BYTES = 73728 + 16;
constexpr size_t OFF_Y0 = OFF_ZA, OFF_H = OFF_ZA, OFF_BR = OFF_RWW, OFF_MRG = OFF_RWR, OFF_FCTX = OFF_RWG;
constexpr size_t OUT_Y1 = 0, OUT_Y2 = 36 * MiB, OUT_ATQ = 72 * MiB, OUT_ATK = 90 * MiB, OUT_ATO = 99 * MiB;
constexpr size_t RWSZ = (size_t)ROWS_ * 256;

struct P {
  const float* in[36];
  float* out;
  char* ws;
};

DEV int opaque_tid() {
  int t = threadIdx.x;
  asm volatile("" : "+v"(t));
  return t;
}
DEV float bf2f(bf16_t v) { return __uint_as_float(((unsigned)v) << 16); }
typedef float f2_t __attribute__((ext_vector_type(2)));
typedef __bf16 b2_t __attribute__((ext_vector_type(2)));
DEV unsigned pack2(float a, float b) {
  f2_t v = {a, b};
  b2_t r = __builtin_convertvector(v, b2_t);
  return __builtin_bit_cast(unsigned, r);
}
DEV bf16_t f2bf(float f) { return (bf16_t)(pack2(f, 0.f) & 0xFFFFu); }
DEV float sigmoidf_(float x) { return 1.f / (1.f + __expf(-x)); }
DEV float siluf_(float x) { return x / (1.f + __expf(-x)); }
DEV float dpp_add_(float v, const int ctrl_sel) {
  int x = __float_as_int(v);
  int y = (ctrl_sel == 0)   ? __builtin_amdgcn_update_dpp(0, x, 0xB1, 0xF, 0xF, true)
          : (ctrl_sel == 1) ? __builtin_amdgcn_update_dpp(0, x, 0x4E, 0xF, 0xF, true)
          : (ctrl_sel == 2) ? __builtin_amdgcn_update_dpp(0, x, 0x141, 0xF, 0xF, true)
                            : __builtin_amdgcn_update_dpp(0, x, 0x140, 0xF, 0xF, true);
  return v + __int_as_float(y);
}
DEV float wave_sum(float v) {
  v = dpp_add_(v, 0);
  v = dpp_add_(v, 1);
  v = dpp_add_(v, 2);
  v = dpp_add_(v, 3);
  const int x = __float_as_int(v);
  const float s0 = __int_as_float(__builtin_amdgcn_readlane(x, 0)), s1 = __int_as_float(__builtin_amdgcn_readlane(x, 16));
  const float s2 = __int_as_float(__builtin_amdgcn_readlane(x, 32)), s3 = __int_as_float(__builtin_amdgcn_readlane(x, 48));
  return (s0 + s1) + (s2 + s3);
}
DEV float reduce8(float v) {
  v = dpp_add_(v, 0);
  v = dpp_add_(v, 1);
  v = dpp_add_(v, 2);
  return v;
}
DEV float reduce16(float v) { return dpp_add_(reduce8(v), 3); }
DEV void unpack8(const uint4& u, float (&f)[8]) {
  f[0] = __uint_as_float(u.x << 16); f[1] = __uint_as_float(u.x & 0xFFFF0000u);
  f[2] = __uint_as_float(u.y << 16); f[3] = __uint_as_float(u.y & 0xFFFF0000u);
  f[4] = __uint_as_float(u.z << 16); f[5] = __uint_as_float(u.z & 0xFFFF0000u);
  f[6] = __uint_as_float(u.w << 16); f[7] = __uint_as_float(u.w & 0xFFFF0000u);
}
DEV uint4 pack8(const float (&f)[8]) {
  uint4 u;
  u.x = pack2(f[0], f[1]); u.y = pack2(f[2], f[3]); u.z = pack2(f[4], f[5]); u.w = pack2(f[6], f[7]);
  return u;
}
DEV void ld8f(const float* p, float (&f)[8]) {
  float4 a = *(const float4*)p, b = *(const float4*)(p + 4);
  f[0] = a.x; f[1] = a.y; f[2] = a.z; f[3] = a.w; f[4] = b.x; f[5] = b.y; f[6] = b.z; f[7] = b.w;
}
DEV float f4c(const float4& v, int c) { return c == 0 ? v.x : (c == 1 ? v.y : (c == 2 ? v.z : v.w)); }

DEV const float* xin_row(const P& p, int l, int row) {
  if (l == 0) {
    int b = row / T_, t = row - b * T_;
    return t < NC_ ? p.in[2] + ((size_t)(b * NC_ + t)) * D_ : p.in[0] + ((size_t)(b * NL_ + t - NC_)) * D_;
  }
  return (const float*)(p.ws + OFF_XA) + (size_t)row * D_;
}
DEV const float* mod_row(const P& p, int l, int row) {
  int b = row / T_, t = row - b * T_;
  return (const float*)(p.ws + OFF_MOD) + (size_t)(l * 17 + (t < NC_ ? 16 : b)) * 6144;
}
DEV bf16_t* u2_row(const P& p, int row) {
  return (row < 18432) ? (bf16_t*)(p.ws + OFF_ZD) + (size_t)row * D_ : (bf16_t*)(p.ws + OFF_RWA) + (size_t)(row - 18432) * D_;
}
DEV int map_row(int l, int mrow) { return l == 0 ? mrow : (mrow >> 11) * T_ + NC_ + (mrow & 2047); }
DEV int n_mrows(int l) { return l == 0 ? ROWS_ : NB_ * NL_; }

DEV void conv_tile(const float* src, bf16_t* dst, int K, int N, int nmat, int t, float* lds, const int tid) {
  const int tn = N >> 6, tpm = (K >> 6) * tn;
  const int m = t / tpm, rem = t - m * tpm, k0 = (rem / tn) << 6, n0 = (rem % tn) << 6;
  const float* S = src + (size_t)m * K * N;
  bf16_t* Dd = dst + (size_t)m * K * N;
  __syncthreads();
#pragma unroll
  for (int ps = 0; ps < 4; ++ps) {
    int kr = (tid >> 4) + 16 * ps, nq = tid & 15;
    float4 v = *(const float4*)(S + (size_t)(k0 + kr) * N + n0 + 4 * nq);
    float* d = lds + kr * 65 + 4 * nq;
    d[0] = v.x; d[1] = v.y; d[2] = v.z; d[3] = v.w;
  }
  __syncthreads();
#pragma unroll
  for (int ps = 0; ps < 2; ++ps) {
    int c = tid + 256 * ps, n = c >> 3, kc = c & 7;
    const float* sp = lds + (8 * kc) * 65 + n;
    uint4 o;
    o.x = pack2(sp[0], sp[65]);
    o.y = pack2(sp[2 * 65], sp[3 * 65]);
    o.z = pack2(sp[4 * 65], sp[5 * 65]);
    o.w = pack2(sp[6 * 65], sp[7 * 65]);
    *(uint4*)(Dd + (size_t)(n0 + n) * K + k0 + 8 * kc) = o;
  }
}
DEV void conv_batch(const float* src, bf16_t* dst, int K, int N, int nmat, float* lds, const int tid) {
  const int nt = nmat * (K >> 6) * (N >> 6);
  for (int t = blockIdx.x; t < nt; t += gridDim.x) conv_tile(src, dst, K, N, nmat, t, lds, tid);
}

struct GemmSmem {
  bf16_t a[2][128 * 40];
  bf16_t b[2][2][128 * 40];
};

typedef unsigned u4v __attribute__((ext_vector_type(4)));
typedef float f4v __attribute__((ext_vector_type(4)));
struct ALModX {
  const float* xp[2];
  const float* mp[2];
  struct Raw { f4v x00, x01, x10, x11, h0, h1, s0, s1; };
  template <int MI>
  DEV void issue(int k, Raw& rw) const {
    rw.h0 = *(const f4v*)(mp[0] + k); rw.h1 = *(const f4v*)(mp[0] + k + 4);
    rw.s0 = *(const f4v*)(mp[0] + 1024 + k); rw.s1 = *(const f4v*)(mp[0] + 1024 + k + 4);
    rw.x00 = *(const f4v*)(xp[0] + k); rw.x01 = *(const f4v*)(xp[0] + k + 4);
    if (MI > 1) { rw.x10 = *(const f4v*)(xp[1] + k); rw.x11 = *(const f4v*)(xp[1] + k + 4); }
  }
  DEV u4v cvt(const f4v& x0, const f4v& x1, const Raw& rw) const {
    u4v o;
    o.x = pack2(x0.x * (1.f + rw.s0.x) + rw.h0.x, x0.y * (1.f + rw.s0.y) + rw.h0.y);
    o.y = pack2(x0.z * (1.f + rw.s0.z) + rw.h0.z, x0.w * (1.f + rw.s0.w) + rw.h0.w);
    o.z = pack2(x1.x * (1.f + rw.s1.x) + rw.h1.x, x1.y * (1.f + rw.s1.y) + rw.h1.y);
    o.w = pack2(x1.z * (1.f + rw.s1.z) + rw.h1.z, x1.w * (1.f + rw.s1.w) + rw.h1.w);
    return o;
  }
  template <int MI>
  DEV void finish(const Raw& rw, u4v& a0, u4v& a1) const {
    a0 = cvt(rw.x00, rw.x01, rw);
    if (MI > 1) a1 = cvt(rw.x10, rw.x11, rw);
  }
};
struct ALBf {
  const bf16_t* ap[2];
  struct Raw { u4v v0, v1; };
  template <int MI>
  DEV void issue(int k, Raw& rw) const {
    rw.v0 = *(const u4v*)(ap[0] + k);
    if (MI > 1) rw.v1 = *(const u4v*)(ap[1] + k);
  }
  template <int MI>
  DEV void finish(const Raw& rw, u4v& a0, u4v& a1) const {
    a0 = rw.v0;
    if (MI > 1) a1 = rw.v1;
  }
};

struct ALBfIdx {
  const bf16_t* base;
  unsigned off[2];
  struct Raw { u4v v0, v1; };
  template <int MI>
  DEV void issue(int k, Raw& rw) const {
    rw.v0 = *(const u4v*)(base + (off[0] + (unsigned)k));
    if (MI > 1) rw.v1 = *(const u4v*)(base + (off[1] + (unsigned)k));
  }
  template <int MI>
  DEV void finish(const Raw& rw, u4v& a0, u4v& a1) const {
    a0 = rw.v0;
    if (MI > 1) a1 = rw.v1;
  }
};

template <int NBM, int MI, class AL>
DEV void gemm_core(const AL& al, const bf16_t* B0, const bf16_t* B1, int ldb, int K, GemmSmem* sm,
                   f32x16 (&acc)[NBM][MI][2], const int tid) {
  const int lane = tid & 63, w = tid >> 6, wm = w >> 1, wn = w & 1, r = lane & 31, h = lane >> 5;
  typedef typename AL::Raw RawT;
  struct RB { u4v b0, b1, b2, b3; };
  RawT rawA, rawB;
  RB rbA, rbB;
  const bf16_t* Bp0 = B0 + (size_t)(tid >> 2) * ldb + 8 * (tid & 3);
  const bf16_t* Bp1 = (NBM > 1) ? (B1 + (size_t)(tid >> 2) * ldb + 8 * (tid & 3)) : Bp0;
  const size_t bstep = (size_t)64 * ldb;
  auto gload = [&](int k0, RawT& raw, RB& rb) __attribute__((always_inline)) {
    al.template issue<MI>(k0 + 8 * (tid & 3), raw);
    rb.b0 = *(const u4v*)(Bp0 + k0);
    rb.b1 = *(const u4v*)(Bp0 + k0 + bstep);
    if (NBM > 1) {
      rb.b2 = *(const u4v*)(Bp1 + k0);
      rb.b3 = *(const u4v*)(Bp1 + k0 + bstep);
    }
  };
  auto lstore = [&](int buf, const RawT& raw, const RB& rb) __attribute__((always_inline)) {
    u4v a0, a1;
    al.template finish<MI>(raw, a0, a1);
    const int o0 = (tid >> 2) * 40 + 8 * (tid & 3), o1 = o0 + 64 * 40;
    *(u4v*)&sm->a[buf][o0] = a0;
    if (MI > 1) *(u4v*)&sm->a[buf][o1] = a1;
    *(u4v*)&sm->b[buf][0][o0] = rb.b0;
    *(u4v*)&sm->b[buf][0][o1] = rb.b1;
    if (NBM > 1) {
      *(u4v*)&sm->b[buf][1][o0] = rb.b2;
      *(u4v*)&sm->b[buf][1][o1] = rb.b3;
    }
  };
  auto compute = [&](int buf) __attribute__((always_inline)) {
#pragma unroll
    for (int ks = 0; ks < 2; ++ks) {
      bf16x8 af[MI], bfr[NBM][2];
#pragma unroll
      for (int mi = 0; mi < MI; ++mi)
        af[mi] = *(const bf16x8*)&sm->a[buf][(32 * MI * wm + 32 * mi + r) * 40 + ks * 16 + 8 * h];
#pragma unroll
      for (int nb = 0; nb < NBM; ++nb)
#pragma unroll
        for (int ni = 0; ni < 2; ++ni)
          bfr[nb][ni] = *(const bf16x8*)&sm->b[buf][nb][(64 * wn + 32 * ni + r) * 40 + ks * 16 + 8 * h];
#pragma unroll
      for (int nb = 0; nb < NBM; ++nb)
#pragma unroll
        for (int mi = 0; mi < MI; ++mi)
#pragma unroll
          for (int ni = 0; ni < 2; ++ni)
            acc[nb][mi][ni] = __builtin_amdgcn_mfma_f32_32x32x16_bf16(af[mi], bfr[nb][ni], acc[nb][mi][ni], 0, 0, 0);
    }
  };
  const int KT = K >> 5;
  const int klast = K - 32;
  gload(0, rawA, rbA);
  gload(32, rawB, rbB);
  lstore(0, rawA, rbA);
  __syncthreads();
  for (int kt = 0; kt < KT; kt += 2) {
    gload(min((kt + 2) << 5, klast), rawA, rbA);
    compute(0);
    lstore(1, rawB, rbB);
    __syncthreads();
    gload(min((kt + 3) << 5, klast), rawB, rbB);
    compute(1);
    lstore(0, rawA, rbA);
    __syncthreads();
  }
}

struct GemmSmem64 {
  bf16_t a[2][128 * 72];
  bf16_t b[2][128 * 72];
};
template <int MI>
DEV void gemm64(const bf16_t* const (&ap)[4], const bf16_t* B, int ldb, int K, GemmSmem64* sm, f32x16 (&acc)[1][MI][2],
                const int tid) {
  const int lane = tid & 63, w = tid >> 6, wm = w >> 1, wn = w & 1, r = lane & 31, h = lane >> 5;
  struct St { u4v a0, a1, a2, a3, b0, b1, b2, b3; };
  St sA, sB;
  const int kc8 = 8 * (tid & 7);
  const bf16_t* Bp = B + (size_t)(tid >> 3) * ldb + kc8;
  const size_t bstep = (size_t)32 * ldb;
  auto gload = [&](int k0, St& st) __attribute__((always_inline)) {
    st.a0 = *(const u4v*)(ap[0] + k0 + kc8);
    st.a1 = *(const u4v*)(ap[1] + k0 + kc8);
    if (MI > 1) {
      st.a2 = *(const u4v*)(ap[2] + k0 + kc8);
      st.a3 = *(const u4v*)(ap[3] + k0 + kc8);
    }
    st.b0 = *(const u4v*)(Bp + k0);
    st.b1 = *(const u4v*)(Bp + k0 + bstep);
    st.b2 = *(const u4v*)(Bp + k0 + 2 * bstep);
    st.b3 = *(const u4v*)(Bp + k0 + 3 * bstep);
  };
  auto lstore = [&](int buf, const St& st) __attribute__((always_inline)) {
    const int o0 = (tid >> 3) * 72 + kc8;
    *(u4v*)&sm->a[buf][o0] = st.a0;
    *(u4v*)&sm->a[buf][o0 + 32 * 72] = st.a1;
    if (MI > 1) {
      *(u4v*)&sm->a[buf][o0 + 64 * 72] = st.a2;
      *(u4v*)&sm->a[buf][o0 + 96 * 72] = st.a3;
    }
    *(u4v*)&sm->b[buf][o0] = st.b0;
    *(u4v*)&sm->b[buf][o0 + 32 * 72] = st.b1;
    *(u4v*)&sm->b[buf][o0 + 64 * 72] = st.b2;
    *(u4v*)&sm->b[buf][o0 + 96 * 72] = st.b3;
  };
  auto compute = [&](int buf) __attribute__((always_inline)) {
#pragma unroll
    for (int ks = 0; ks < 4; ++ks) {
      bf16x8 af[MI], bfr[2];
#pragma unroll
      for (int mi = 0; mi < MI; ++mi)
        af[mi] = *(const bf16x8*)&sm->a[buf][(32 * MI * wm + 32 * mi + r) * 72 + ks * 16 + 8 * h];
#pragma unroll
      for (int ni = 0; ni < 2; ++ni) bfr[ni] = *(const bf16x8*)&sm->b[buf][(64 * wn + 32 * ni + r) * 72 + ks * 16 + 8 * h];
#pragma unroll
      for (int mi = 0; mi < MI; ++mi)
#pragma unroll
        for (int ni = 0; ni < 2; ++ni)
          acc[0][mi][ni] = __builtin_amdgcn_mfma_f32_32x32x16_bf16(af[mi], bfr[ni], acc[0][mi][ni], 0, 0, 0);
    }
  };
  const int KT = K >> 6;
  const int klast = K - 64;
  gload(0, sA);
  gload(64, sB);
  lstore(0, sA);
  __syncthreads();
  for (int kt = 0; kt < KT; kt += 2) {
    gload(min((kt + 2) << 6, klast), sA);
    compute(0);
    lstore(1, sB);
    __syncthreads();
    gload(min((kt + 3) << 6, klast), sB);
    compute(1);
    lstore(0, sA);
    __syncthreads();
  }
}

template <int NBM, int MI>
DEV void acc_zero(f32x16 (&acc)[NBM][MI][2]) {
#pragma unroll
  for (int nb = 0; nb < NBM; ++nb)
#pragma unroll
    for (int mi = 0; mi < MI; ++mi)
#pragma unroll
      for (int ni = 0; ni < 2; ++ni)
#pragma unroll
        for (int e = 0; e < 16; ++e) acc[nb][mi][ni][e] = 0.f;
}
#define ACC_ROW(mi, reg) (64 * wm + 32 * (mi) + ((reg) & 3) + 8 * ((reg) >> 2) + 4 * h)
#define ACC_COL(ni) (64 * wn + 32 * (ni) + r)
#define ACC_IDS                                                                                     \
  const int tid = opaque_tid(), lane = tid & 63, w = tid >> 6, wm = w >> 1, wn = w & 1, r = lane & 31, \
            h = lane >> 5;                                                                          \
  (void)tid; (void)lane; (void)w; (void)wm; (void)wn; (void)r; (void)h;

DEV void phase_mod(const P& p, char* smem) {
  float* sc = (float*)smem;
  float* red = sc + 17 * 256;
  const int tid = opaque_tid(), kg = tid >> 5, cn = tid & 31;
  float* MOD = (float*)(p.ws + OFF_MOD);
  for (int i = blockIdx.x * 256 + tid; i < 4 * 8448; i += gridDim.x * 256) ((int*)(p.ws + OFF_SCH))[i] = 0;
  for (int task = blockIdx.x; task < 384; task += gridDim.x) {
    const int l = task / 192, n0 = (task % 192) * 32;
    const float* W = p.in[4] + (size_t)l * 1024 * 6144;
    float acc[17];
#pragma unroll
    for (int i = 0; i < 17; ++i) acc[i] = 0.f;
    for (int s = 0; s < 4; ++s) {
      __syncthreads();
      for (int i = tid; i < 17 * 256; i += 256) {
        int rr = i >> 8, k = i & 255;
        float c = (rr < 16) ? p.in[1][rr * 1024 + s * 256 + k] : p.in[3][s * 256 + k];
        sc[i] = siluf_(c);
      }
      __syncthreads();
#pragma unroll 8
      for (int kk = 0; kk < 32; ++kk) {
        int k = kg * 32 + kk;
        float wv = W[(size_t)(s * 256 + k) * 6144 + n0 + cn];
#pragma unroll
        for (int rr = 0; rr < 17; ++rr) acc[rr] += sc[rr * 256 + k] * wv;
      }
    }
#pragma unroll
    for (int rr = 0; rr < 17; ++rr) red[(kg * 17 + rr) * 32 + cn] = acc[rr];
    __syncthreads();
    for (int i = tid; i < 17 * 32; i += 256) {
      int rr = i >> 5, c = i & 31;
      float v = 0.f;
#pragma unroll
      for (int g = 0; g < 8; ++g) v += red[(g * 17 + rr) * 32 + c];
      MOD[(size_t)(l * 17 + rr) * 6144 + n0 + c] = v + p.in[5][l * 6144 + n0 + c];
    }
    __syncthreads();
  }
  float* COS = (float*)(p.ws + OFF_COS);
  float* SIN = (float*)(p.ws + OFF_SIN);
  for (int i = blockIdx.x * 256 + tid; i < 2048 * 32; i += gridDim.x * 256) {
    int n = i >> 5, j = i & 31;
    int rowi = n >> 6, coli = n & 63;
    float inv = powf(10000.f, -(float)(j & 15) / 16.f);
    float ang = (float)(j < 16 ? rowi : coli) * inv;
    COS[i] = cosf(ang);
    SIN[i] = sinf(ang);
  }
  conv_batch(p.in[6], (bf16_t*)(p.ws + OFF_WINT), 1024, 3968, 1, (float*)smem, tid);
  conv_batch(p.in[9], (bf16_t*)(p.ws + OFF_LW), 64, 256, 4, (float*)smem, tid);
  conv_batch(p.in[11], (bf16_t*)(p.ws + OFF_LW) + 65536, 64, 256, 4, (float*)smem, tid);
  conv_batch(p.in[12], (bf16_t*)(p.ws + OFF_LW) + 131072, 128, 256, 2, (float*)smem, tid);
}

DEV bool tile_map(int it, int R, int C, int& rt, int& ct) {
  const int x = blockIdx.x & 7, j = blockIdx.x >> 3, nb8 = gridDim.x >> 3;
  const int q = it * nb8 + j;
  const int s = (q >> 6) * 8 + x, w = q & 63;
  const int c8 = C >> 3;
  if (s >= (R >> 3) * c8) return false;
  const int sr = s / c8, sc = s - sr * c8;
  rt = sr * 8 + (w >> 3);
  ct = sc * 8 + (w & 7);
  return true;
}

DEV void store_rowpair_bf16(bf16_t* base, size_t ld, int R, int c, float ve, float ve1) {
  const bool odd = (c & 1) != 0;
  const float snd = odd ? ve : ve1;
  const float rcv = __int_as_float(__builtin_amdgcn_update_dpp(0, __float_as_int(snd), 0xB1, 0xF, 0xF, true));
  const unsigned pk = odd ? pack2(rcv, ve1) : pack2(ve, rcv);
  *(unsigned*)(base + (size_t)(odd ? R + 1 : R) * ld + (odd ? c - 1 : c)) = pk;
}

DEV void write_u_row(const P& p, int lnext, int row, const float4& x, int n) {
  const float* mr = mod_row(p, lnext, row);
  float4 sh = *(const float4*)(mr + n), sc = *(const float4*)(mr + 1024 + n);
  uint2 o;
  o.x = pack2(x.x * (1.f + sc.x) + sh.x, x.y * (1.f + sc.y) + sh.y);
  o.y = pack2(x.z * (1.f + sc.z) + sh.z, x.w * (1.f + sc.w) + sh.w);
  *(uint2*)((bf16_t*)(p.ws + OFF_U) + (size_t)row * D_ + n) = o;
}
DEV void phase_u(const P& p, char* smem) {
  const int tid = opaque_tid(), n = tid * 4;
  for (int row = blockIdx.x; row < ROWS_; row += gridDim.x) {
    float4 x = *(const float4*)(xin_row(p, 0, row) + n);
    write_u_row(p, 0, row, x, n);
  }
}

DEV void phase_in(const P& p, int l, char* smem) {
  GemmSmem* sm = (GemmSmem*)smem;
  ACC_IDS
  const bf16_t* WT = (const bf16_t*)(p.ws + (l == 0 ? OFF_WINT : OFF_WINT1));
  int mt, np;
  for (int it = 0; tile_map(it, 288, 16, mt, np); ++it) {
    ALBf al;
#pragma unroll
    for (int i = 0; i < 2; ++i) al.ap[i] = (const bf16_t*)(p.ws + OFF_U) + (size_t)(mt * 128 + (tid >> 2) + 64 * i) * D_;
    f32x16 acc[2][2][2];
    acc_zero<2, 2>(acc);
    const bf16_t* B0 = WT + (size_t)(np * 256) * 1024;
    const bf16_t* B1 = (np < 15) ? B0 + (size_t)128 * 1024 : B0;
    gemm_core<2, 2>(al, B0, B1, 1024, 1024, sm, acc, tid);
#pragma unroll
    for (int nb = 0; nb < 2; ++nb) {
      const int nt = 2 * np + nb;
      if (nt < 31) {
        bf16_t* Z;
        int ld, c0;
        if (nt < 9) { Z = (bf16_t*)(p.ws + OFF_ZA); ld = 1152; c0 = nt * 128; }
        else if (nt < 17) { Z = (bf16_t*)(p.ws + OFF_ZB); ld = 1024; c0 = (nt - 9) * 128; }
        else if (nt < 27) { Z = (bf16_t*)(p.ws + OFF_ZC); ld = 1280; c0 = (nt - 17) * 128; }
        else { Z = (bf16_t*)(p.ws + OFF_ZD); ld = 512; c0 = (nt - 27) * 128; }
#pragma unroll
        for (int mi = 0; mi < 2; ++mi)
#pragma unroll
          for (int ni = 0; ni < 2; ++ni)
#pragma unroll
            for (int e = 0; e < 16; e += 2)
              store_rowpair_bf16(Z, ld, mt * 128 + ACC_ROW(mi, e), c0 + ACC_COL(ni), acc[nb][mi][ni][e], acc[nb][mi][ni][e + 1]);
      }
    }
  }
}

DEV float za_mix(const bf16_t* ZA, const float* mu, int b, int t, int col) {
  const bf16_t* z = ZA + ((size_t)b * T_ + t) * 1152 + col;
  float zc = bf2f(z[0]);
  bool hasl = (t != 0 && t != NC_), hasr = (t != NC_ - 1 && t != T_ - 1);
  float zl = hasl ? bf2f(z[-1152]) : 0.f;
  float zr = hasr ? bf2f(z[1152]) : 0.f;
  return zc + mu[col] * (0.5f * (zl + zr) - zc);
}

DEV void za_mix8(const bf16_t* ZA, const float (&mu)[8], int b, int t, int col, float (&o)[8]) {
  const bf16_t* z = ZA + ((size_t)b * T_ + t) * 1152 + col;
  const bool hasl = (t != 0 && t != NC_), hasr = (t != NC_ - 1 && t != T_ - 1);
  const uint4 zero4 = make_uint4(0, 0, 0, 0);
  uint4 uc = *(const uint4*)z;
  uint4 ul = hasl ? *(const uint4*)(z - 1152) : zero4;
  uint4 ur = hasr ? *(const uint4*)(z + 1152) : zero4;
  float c[8], lft[8], rgt[8];
  unpack8(uc, c); unpack8(ul, lft); unpack8(ur, rgt);
#pragma unroll
  for (int j = 0; j < 8; ++j) o[j] = c[j] + mu[j] * (0.5f * (lft[j] + rgt[j]) - c[j]);
}

DEV void phase_prep(const P& p, int l, char* smem) {
  const int tid = opaque_tid(), lane = tid & 63, wv = tid >> 6;
  const bf16_t* ZA = (const bf16_t*)(p.ws + OFF_ZA);
  const bf16_t* ZD = (const bf16_t*)(p.ws + OFF_ZD);
  const float* mu = p.in[7] + l * 1152;
  bf16_t* RWR = (bf16_t*)(p.ws + OFF_RWR);
  bf16_t* RWK = RWR + RWSZ;
  bf16_t* RWV = RWK + RWSZ;
  bf16_t* RWKK = RWV + RWSZ;
  bf16_t* RWBG = (bf16_t*)(p.ws + OFF_RWG) + RWSZ;
  bf16_t* LI = (bf16_t*)((char*)p.out + OUT_Y1);
  bf16_t* ATQ = (bf16_t*)((char*)p.out + OUT_ATQ);
  bf16_t* ATK = (bf16_t*)((char*)p.out + OUT_ATK);
  const float* COS = (const float*)(p.ws + OFF_COS);
  const float* SIN = (const float*)(p.ws + OFF_SIN);
  const int gw = blockIdx.x * 4 + wv, nw = gridDim.x * 4;
  {
    const int c8 = (lane & 31) * 8;
    float mur[8], muk[8], muv[8], kkw[8], rkw[8];
    ld8f(mu + c8, mur); ld8f(mu + 256 + c8, muk); ld8f(mu + 512 + c8, muv);
    ld8f(p.in[13] + l * 256 + c8, kkw); ld8f(p.in[15] + l * 256 + c8, rkw);
#pragma unroll 2
    for (int pr = gw; pr < ROWS_ / 2; pr += nw) {
      const int row = 2 * pr + (lane >> 5);
      const int b = row / T_, t = row - b * T_;
      float rv[8], kv[8], vv[8];
      za_mix8(ZA, mur, b, t, c8, rv);
      za_mix8(ZA, muk, b, t, 256 + c8, kv);
      za_mix8(ZA, muv, b, t, 512 + c8, vv);
      float kkf[8], ss = 0.f, rk = 0.f;
#pragma unroll
      for (int j = 0; j < 8; ++j) { kkf[j] = kv[j] * kkw[j]; ss += kkf[j] * kkf[j]; rk += rv[j] * kv[j] * rkw[j]; }
      ss = reduce8(ss);
      rk = reduce8(rk);
      const float rn = rsqrtf(ss + 1e-12f);
      float bon[8];
#pragma unroll
      for (int j = 0; j < 8; ++j) { kkf[j] *= rn; bon[j] = rk * vv[j]; }
      const size_t o = (size_t)row * 256 + c8;
      *(uint4*)(RWR + o) = pack8(rv);
      *(uint4*)(RWK + o) = pack8(kv);
      *(uint4*)(RWV + o) = pack8(vv);
      *(uint4*)(RWKK + o) = pack8(kkf);
      *(uint4*)(RWBG + o) = pack8(bon);
#pragma unroll
      for (int ps = 0; ps < 2; ++ps) {
        const int id = lane + 64 * ps;
        if (id < 96) {
          const int rs = id / 48, ck = id - rs * 48;
          const int row2 = 2 * pr + rs;
          const int b2 = row2 / T_, t2 = row2 - b2 * T_;
          float mul[8], lv[8];
          ld8f(mu + 768 + ck * 8, mul);
          za_mix8(ZA, mul, b2, t2, 768 + ck * 8, lv);
          if (ck < 16) {
#pragma unroll
            for (int j = 0; j < 8; ++j) lv[j] = tanhf(lv[j]);
          } else if (ck >= 32) {
#pragma unroll
            for (int j = 0; j < 8; ++j) lv[j] = sigmoidf_(lv[j]);
          }
          *(uint4*)(LI + (size_t)row2 * 384 + ck * 8) = pack8(lv);
        }
      }
    }
  }
  {
    const int hc = lane & 7;
    const bool isq = lane < 32, act = lane < 48;
    float gown[8], gpar[8];
    const float* gsrc = (isq ? p.in[23] : p.in[24]) + l * 64;
    ld8f(gsrc + hc * 8, gown);
    ld8f(gsrc + (hc ^ 4) * 8, gpar);
#pragma unroll 2
    for (int row = gw; row < ROWS_; row += nw) {
      const int t = row % T_;
      if (act) {
        const bf16_t* z = ZD + (size_t)row * 512;
        float xo[8], xp[8];
        unpack8(*(const uint4*)(z + lane * 8), xo);
        unpack8(*(const uint4*)(z + (lane ^ 4) * 8), xp);
        float ss = 0.f;
#pragma unroll
        for (int j = 0; j < 8; ++j) ss += xo[j] * xo[j];
        ss = reduce8(ss);
        const float rn = rsqrtf(ss * (1.f / 64.f) + 1e-6f);
        float cs[8], sn[8];
        if (t >= NC_) {
          ld8f(COS + (t - NC_) * 32 + (hc & 3) * 8, cs);
          ld8f(SIN + (t - NC_) * 32 + (hc & 3) * 8, sn);
        } else {
#pragma unroll
          for (int j = 0; j < 8; ++j) { cs[j] = 1.f; sn[j] = 0.f; }
        }
        float o[8];
        const float scl = isq ? 0.125f : 1.f;
#pragma unroll
        for (int j = 0; j < 8; ++j) {
          const float a = xo[j] * rn * gown[j], bq = xp[j] * rn * gpar[j];
          o[j] = ((hc & 4) == 0 ? (a * cs[j] - bq * sn[j]) : (bq * sn[j] + a * cs[j])) * scl;
        }
        if (isq) *(uint4*)(ATQ + (size_t)row * 256 + lane * 8) = pack8(o);
        else *(uint4*)(ATK + (size_t)row * 128 + (lane - 32) * 8) = pack8(o);
      }
    }
  }
}

DEV void phase_prep2(const P& p, int l, char* smem) {
  GemmSmem* sm = (GemmSmem*)smem;
  ACC_IDS
  const bf16_t* LI = (const bf16_t*)((const char*)p.out + OUT_Y1);
  const bf16_t* LW = (const bf16_t*)(p.ws + OFF_LW);
  float* RWW = (float*)(p.ws + OFF_RWW);
  bf16_t* RWA = (bf16_t*)(p.ws + OFF_RWA);
  bf16_t* RWG = (bf16_t*)(p.ws + OFF_RWG);
  bf16_t* RWBG = RWG + RWSZ;
  for (int tile = blockIdx.x; tile < 288 * 10; tile += gridDim.x) {
    const int mt = tile / 10, nt = tile % 10;
    const int kind = nt >> 1, chalf = nt & 1;
    const int K = (kind == 4) ? 128 : 64;
    const int koff = (kind == 4) ? 256 : kind * 64;
    const bf16_t* Bt;
    if (kind < 2) Bt = LW + (size_t)((l * 2 + kind) * 256) * 64;
    else if (kind < 4) Bt = LW + 65536 + (size_t)((l * 2 + (kind - 2)) * 256) * 64;
    else Bt = LW + 131072 + (size_t)(l * 256) * 128;
    Bt += (size_t)(chalf * 128) * K;
    ALBf al;
#pragma unroll
    for (int i = 0; i < 2; ++i) al.ap[i] = LI + (size_t)(mt * 128 + (tid >> 2) + 64 * i) * 384 + koff;
    f32x16 acc[1][2][2];
    acc_zero<1, 2>(acc);
    gemm_core<1, 2>(al, Bt, nullptr, K, K, sm, acc, tid);
    const int d = kind & 1;
#pragma unroll
    for (int ni = 0; ni < 2; ++ni) {
      const int ch = chalf * 128 + ACC_COL(ni);
      const float c0 = (kind < 2) ? p.in[8][(l * 2 + d) * 256 + ch] : ((kind < 4) ? p.in[10][(l * 2 + d) * 256 + ch] : 0.f);
#pragma unroll
      for (int mi = 0; mi < 2; ++mi)
#pragma unroll
        for (int e = 0; e < 16; e += 2) {
          const int R = mt * 128 + ACC_ROW(mi, e);
          const size_t o = (size_t)R * 256 + ch;
          const float v0 = acc[0][mi][ni][e], v1 = acc[0][mi][ni][e + 1];
          if (kind < 2) {
            float x0 = -(c0 + v0), x1 = -(c0 + v1);
            float sp0 = fmaxf(x0, 0.f) + log1pf(__expf(-fabsf(x0))), sp1 = fmaxf(x1, 0.f) + log1pf(__expf(-fabsf(x1)));
            RWW[(size_t)d * RWSZ + o] = __expf(-__expf(-sp0 - 0.5f));
            RWW[(size_t)d * RWSZ + o + 256] = __expf(-__expf(-sp1 - 0.5f));
          } else if (kind < 4) {
            store_rowpair_bf16(RWA + (size_t)d * RWSZ, 256, R, ch, sigmoidf_(c0 + v0), sigmoidf_(c0 + v1));
          } else {
            const float b0 = bf2f(RWBG[o]), b1 = bf2f(RWBG[o + 256]);
            store_rowpair_bf16(RWG, 256, R, ch, v0, v1);
            store_rowpair_bf16(RWBG, 256, R, ch, b0 * v0, b1 * v1);
          }
        }
    }
  }
}

DEV int scan_tok(int d, int j) { return d == 0 ? j : (j < NC_ ? NC_ - 1 - j : (T_ + NC_ - 1) - j); }

DEV float quad_sum(float v) {
  v += __int_as_float(__builtin_amdgcn_update_dpp(0, __float_as_int(v), 0xB1, 0xF, 0xF, true));
  v += __int_as_float(__builtin_amdgcn_update_dpp(0, __float_as_int(v), 0x4E, 0xF, 0xF, true));
  return v;
}

constexpr int SCH = 16;
constexpr int SCHF = SCH * 384;
template <int MIX, int LPR>
DEV void scan_block(const P& p, int l, int task0, float* LB, const int tid) {
  constexpr int NF = 16 / LPR;
  const int lane = tid & 63, wv = tid >> 6;
  const int task = (LPR == 8) ? (task0 >> 1) : task0;
  const int rowbase = (LPR == 8) ? 32 * (task0 & 1) : 0;
  const int d = task & 1, hh = (task >> 1) & 3, b = task >> 3;
  const int c = hh * 64 + lane;
  const int col = rowbase + (64 / LPR) * wv + (lane / LPR), q = lane & (LPR - 1);
  f2_t S2[2 * NF];
#pragma unroll
  for (int i = 0; i < 2 * NF; ++i) S2[i] = (f2_t){0.f, 0.f};
  const float* RWW = (const float*)(p.ws + OFF_RWW) + (size_t)d * RWSZ;
  const bf16_t* RWA = (const bf16_t*)(p.ws + OFF_RWA) + (size_t)d * RWSZ;
  const bf16_t* RWR = (const bf16_t*)(p.ws + OFF_RWR);
  const bf16_t* RWK = RWR + RWSZ;
  const bf16_t* RWV = RWK + RWSZ;
  const bf16_t* RWKK = RWV + RWSZ;
  const bf16_t* ZB = (const bf16_t*)(p.ws + OFF_ZB);
  const bf16_t* ZC = (const bf16_t*)(p.ws + OFF_ZC);
  const float* COS = (const float*)(p.ws + OFF_COS);
  const float* SIN = (const float*)(p.ws + OFF_SIN);
  bf16_t* Y = (MIX == 0) ? (bf16_t*)(p.ws + OFF_Y0)
                         : (MIX == 1 ? (bf16_t*)((char*)p.out + OUT_Y1) : (bf16_t*)((char*)p.out + OUT_Y2));
  Y += (size_t)d * RWSZ;
  float cst0 = 0.f, cst1 = 0.f;
  if (MIX == 0) cst0 = p.in[14][l * 256 + c];
  if (MIX == 1) cst0 = sigmoidf_(p.in[18][(l * 2 + d) * 4 + hh]);
  if (MIX == 2) {
    float h0 = p.in[21][(d * 2 + 0) * 256 + c], h1 = p.in[21][(d * 2 + 1) * 256 + c];
    cst0 = (l == 0) ? 0.f : sigmoidf_(h1 - h0);
    cst1 = 1.f - cst0;
  }
  constexpr int NV = (MIX == 0) ? 6 : (MIX == 1 ? 7 : 3);
  constexpr int SPW = SCH / 4;
  float pf[SPW][NV];
  auto issue = [&](int j0) __attribute__((always_inline)) {
#pragma unroll
    for (int s2 = 0; s2 < SPW; ++s2) {
      const int t = scan_tok(d, j0 + SPW * wv + s2);
      const size_t row = (size_t)b * T_ + t;
      if (MIX == 0) {
        pf[s2][0] = RWW[row * 256 + c];
        pf[s2][1] = bf2f(RWA[row * 256 + c]);
        pf[s2][2] = bf2f(RWR[row * 256 + c]);
        pf[s2][3] = bf2f(RWK[row * 256 + c]);
        pf[s2][4] = bf2f(RWKK[row * 256 + c]);
        pf[s2][5] = bf2f(RWV[row * 256 + c]);
      } else if (MIX == 1) {
        const bf16_t* z = ZB + row * 1024;
        pf[s2][0] = bf2f(z[c]);
        pf[s2][1] = bf2f(z[c ^ 32]);
        pf[s2][2] = bf2f(z[256 + c]);
        pf[s2][3] = bf2f(z[256 + (c ^ 32)]);
        pf[s2][4] = bf2f(z[512 + c]);
        if (t >= NC_) {
          pf[s2][5] = COS[(t - NC_) * 32 + (lane & 31)];
          pf[s2][6] = SIN[(t - NC_) * 32 + (lane & 31)];
        } else {
          pf[s2][5] = 1.f;
          pf[s2][6] = 0.f;
        }
      } else {
        const bf16_t* z = ZC + row * 1280;
        pf[s2][0] = bf2f(z[c]);
        pf[s2][1] = bf2f(z[256 + d * 256 + c]);
        pf[s2][2] = bf2f(z[768 + c]);
      }
    }
  };
  auto commit = [&](float* Lb) __attribute__((always_inline)) {
#pragma unroll
    for (int s2 = 0; s2 < SPW; ++s2) {
      float* Ls = Lb + (SPW * wv + s2) * 384;
      if (MIX == 0) {
        float wd = pf[s2][0], a = pf[s2][1], rv = pf[s2][2], kv = pf[s2][3], kk = pf[s2][4], vv = pf[s2][5];
        Ls[lane] = wd;
        Ls[64 + lane] = kk;
        Ls[128 + lane] = kk * a;
        Ls[192 + lane] = kv * (1.f + (a - 1.f) * cst0);
        Ls[256 + lane] = rv;
        Ls[320 + lane] = vv;
      } else if (MIX == 1) {
        float cs = pf[s2][5], sn = pf[s2][6];
        float qq = (lane < 32) ? (pf[s2][0] * cs - pf[s2][1] * sn) : (pf[s2][1] * sn + pf[s2][0] * cs);
        float kk = (lane < 32) ? (pf[s2][2] * cs - pf[s2][3] * sn) : (pf[s2][3] * sn + pf[s2][2] * cs);
        Ls[lane] = qq;
        Ls[64 + lane] = kk * 0.125f;
        Ls[128 + lane] = pf[s2][4];
      } else {
        float x = pf[s2][1];
        float sg = 1.f / (1.f + __expf(-x));
        Ls[lane] = cst0 + cst1 * sg;
        Ls[128 + lane] = siluf_(pf[s2][0]);
        Ls[192 + lane] = pf[s2][2];
      }
    }
  };
  __syncthreads();
  issue(0);
  commit(LB);
  __syncthreads();
  for (int j0 = 0; j0 < T_; j0 += SCH) {
    const int cb = (j0 / SCH) & 1;
    const float* Lc = LB + cb * SCHF;
    float* Ln = LB + (cb ^ 1) * SCHF;
    if (j0 + SCH < T_) issue(j0 + SCH);
    {
      constexpr int NX = ((MIX == 0) ? 4 : 2) * NF;
      f4v XA[NX], XB[NX], KA[NF], KB[NF];
      float vvA, vvB;
      auto ldk = [&](const float* Ls, f4v (&dst)[NF]) __attribute__((always_inline)) {
        const f4v* L4 = (const f4v*)Ls;
#pragma unroll
        for (int i = 0; i < NF; ++i) dst[i] = L4[16 + NF * q + i];
      };
      auto ldx = [&](const float* Ls, f4v (&X)[NX], float& vv) __attribute__((always_inline)) {
        const f4v* L4 = (const f4v*)Ls;
        if (MIX == 0) {
#pragma unroll
          for (int i = 0; i < NF; ++i) {
            X[i] = L4[NF * q + i];
            X[NF + i] = L4[32 + NF * q + i];
            X[2 * NF + i] = L4[48 + NF * q + i];
            X[3 * NF + i] = L4[64 + NF * q + i];
          }
          vv = Ls[320 + col];
        } else if (MIX == 1) {
#pragma unroll
          for (int i = 0; i < NF; ++i) {
            X[i] = L4[NF * q + i];
            X[NF + i] = L4[16 + NF * q + i];
          }
          vv = Ls[128 + col];
        } else {
#pragma unroll
          for (int i = 0; i < NF; ++i) {
            X[i] = L4[NF * q + i];
            X[NF + i] = L4[32 + NF * q + i];
          }
          vv = Ls[192 + col];
        }
      };
      auto lsum = [&](float v) __attribute__((always_inline)) -> float { return (LPR == 8) ? reduce8(v) : quad_sum(v); };
      auto step = [&](const f4v (&kq)[NF], const f4v (&X)[NX], const float vv) __attribute__((always_inline)) -> float {
        f2_t o2a = {0.f, 0.f}, o2b = {0.f, 0.f};
        if (MIX == 0) {
          f2_t a2 = {0.f, 0.f}, b2 = {0.f, 0.f};
#pragma unroll
          for (int i = 0; i < NF; ++i) {
            a2 += S2[2 * i] * kq[i].lo;
            b2 += S2[2 * i + 1] * kq[i].hi;
          }
          a2 += b2;
          const float nskk = -lsum(a2.x + a2.y);
          const f2_t ns2 = {nskk, nskk}, vv2 = {vv, vv};
#pragma unroll
          for (int i = 0; i < NF; ++i) {
            f2_t s0 = S2[2 * i] * X[i].lo + ns2 * X[NF + i].lo + vv2 * X[2 * NF + i].lo;
            f2_t s1 = S2[2 * i + 1] * X[i].hi + ns2 * X[NF + i].hi + vv2 * X[2 * NF + i].hi;
            S2[2 * i] = s0;
            S2[2 * i + 1] = s1;
            o2a += s0 * X[3 * NF + i].lo;
            o2b += s1 * X[3 * NF + i].hi;
          }
        } else if (MIX == 1) {
          const f2_t gm2 = {cst0, cst0}, vv2 = {vv, vv};
#pragma unroll
          for (int i = 0; i < NF; ++i) {
            f2_t s0 = S2[2 * i] * gm2 + X[NF + i].lo * vv2;
            f2_t s1 = S2[2 * i + 1] * gm2 + X[NF + i].hi * vv2;
            S2[2 * i] = s0;
            S2[2 * i + 1] = s1;
            o2a += s0 * X[i].lo;
            o2b += s1 * X[i].hi;
          }
        } else {
          const f2_t vv2 = {vv, vv};
#pragma unroll
          for (int i = 0; i < NF; ++i) {
            f2_t s0 = (S2[2 * i] - vv2) * X[i].lo + vv2;
            f2_t s1 = (S2[2 * i + 1] - vv2) * X[i].hi + vv2;
            S2[2 * i] = s0;
            S2[2 * i + 1] = s1;
            o2a += s0 * X[NF + i].lo;
            o2b += s1 * X[NF + i].hi;
          }
        }
        o2a += o2b;
        return lsum(o2a.x + o2a.y);
      };
      if (MIX == 0) ldk(Lc, KA);
      else ldx(Lc, XA, vvA);
      float keep = 0.f;
#pragma unroll
      for (int s = 0; s < SCH; ++s) {
        float o;
        if (MIX == 0) {
          ldx(Lc + s * 384, XA, vvA);
          if ((s & 1) == 0) {
            if (s + 1 < SCH) ldk(Lc + (s + 1) * 384, KB);
            __builtin_amdgcn_sched_barrier(0);
            o = step(KA, XA, vvA);
          } else {
            if (s + 1 < SCH) ldk(Lc + (s + 1) * 384, KA);
            __builtin_amdgcn_sched_barrier(0);
            o = step(KB, XA, vvA);
          }
        } else {
          if ((s & 1) == 0) {
            if (s + 1 < SCH) ldx(Lc + (s + 1) * 384, XB, vvB);
            __builtin_amdgcn_sched_barrier(0);
            o = step(KA, XA, vvA);
          } else {
            if (s + 1 < SCH) ldx(Lc + (s + 1) * 384, XA, vvA);
            __builtin_amdgcn_sched_barrier(0);
            o = step(KA, XB, vvB);
          }
        }
        keep = ((s & (LPR - 1)) == q) ? o : keep;
        if ((s & (LPR - 1)) == LPR - 1) {
          const int t = scan_tok(d, j0 + (s & ~(LPR - 1)) + q);
          Y[((size_t)b * T_ + t) * 256 + hh * 64 + col] = f2bf(keep);
        }
      }
    }
    if (j0 + SCH < T_) commit(Ln);
    __syncthreads();
  }
}

struct AttSmem {
  bf16_t k[64 * 72];
  bf16_t vt[64 * 72];
};

DEV void attn_task(const P& p, int l, int task, AttSmem* sm, const int tid) {
  const int lane = tid & 63, w = tid >> 6, r = lane & 31, h = lane >> 5;
  int b, hq, q0, nkeys;
  if (task < 1024) { b = task >> 6; hq = (task >> 4) & 3; q0 = NC_ + (task & 15) * 128; nkeys = T_; }
  else { int t2 = task - 1024; b = t2 >> 3; hq = (t2 >> 1) & 3; q0 = (t2 & 1) * 128; nkeys = NC_; }
  const int kvh = hq >> 1;
  const bf16_t* ATQ = (const bf16_t*)((const char*)p.out + OUT_ATQ);
  const bf16_t* ATK = (const bf16_t*)((const char*)p.out + OUT_ATK);
  bf16_t* ATO = (bf16_t*)((char*)p.out + OUT_ATO);
  const bf16_t* ZD = (const bf16_t*)(p.ws + OFF_ZD);
  const size_t qrow = (size_t)b * T_ + q0 + 32 * w + r;
  bf16x8 qf[4];
#pragma unroll
  for (int ks = 0; ks < 4; ++ks) qf[ks] = *(const bf16x8*)(ATQ + qrow * 256 + hq * 64 + 16 * ks + 8 * h);
  f32x16 O[2];
#pragma unroll
  for (int e = 0; e < 16; ++e) { O[0][e] = 0.f; O[1][e] = 0.f; }
  float m = -1e30f, lsum = 0.f;
  u4v kreg0, kreg1, vreg0, vreg1;
  auto kv_issue = [&](int kt) __attribute__((always_inline)) {
    const int q0 = tid, q1 = tid + 256;
    kreg0 = *(const u4v*)(ATK + ((size_t)b * T_ + kt + (q0 >> 3)) * 128 + kvh * 64 + 8 * (q0 & 7));
    kreg1 = *(const u4v*)(ATK + ((size_t)b * T_ + kt + (q1 >> 3)) * 128 + kvh * 64 + 8 * (q1 & 7));
    vreg0 = *(const u4v*)(ZD + ((size_t)b * T_ + kt + (q0 & 63)) * 512 + 384 + kvh * 64 + 8 * (q0 >> 6));
    vreg1 = *(const u4v*)(ZD + ((size_t)b * T_ + kt + (q1 & 63)) * 512 + 384 + kvh * 64 + 8 * (q1 >> 6));
  };
  auto v_scatter = [&](const u4v& vv, int q) __attribute__((always_inline)) {
    const int vkey = q & 63, vdc = q >> 6;
    bf16_t* dst = &sm->vt[(8 * vdc) * 72 + vkey];
    dst[0 * 72] = (bf16_t)(vv.x & 0xFFFFu); dst[1 * 72] = (bf16_t)(vv.x >> 16);
    dst[2 * 72] = (bf16_t)(vv.y & 0xFFFFu); dst[3 * 72] = (bf16_t)(vv.y >> 16);
    dst[4 * 72] = (bf16_t)(vv.z & 0xFFFFu); dst[5 * 72] = (bf16_t)(vv.z >> 16);
    dst[6 * 72] = (bf16_t)(vv.w & 0xFFFFu); dst[7 * 72] = (bf16_t)(vv.w >> 16);
  };
  kv_issue(0);
  for (int kt = 0; kt < nkeys; kt += 64) {
    __syncthreads();
    {
      const int q0 = tid, q1 = tid + 256;
      *(u4v*)&sm->k[(q0 >> 3) * 72 + 8 * (q0 & 7)] = kreg0;
      *(u4v*)&sm->k[(q1 >> 3) * 72 + 8 * (q1 & 7)] = kreg1;
      v_scatter(vreg0, q0);
      v_scatter(vreg1, q1);
    }
    __syncthreads();
    if (kt + 64 < nkeys) kv_issue(kt + 64);
    f32x16 Sx[2];
#pragma unroll
    for (int kb = 0; kb < 2; ++kb) {
#pragma unroll
      for (int e = 0; e < 16; ++e) Sx[kb][e] = 0.f;
#pragma unroll
      for (int ks = 0; ks < 4; ++ks) {
        bf16x8 kf = *(const bf16x8*)&sm->k[(32 * kb + r) * 72 + 16 * ks + 8 * h];
        Sx[kb] = __builtin_amdgcn_mfma_f32_32x32x16_bf16(kf, qf[ks], Sx[kb], 0, 0, 0);
      }
    }
    float mx = -1e30f;
#pragma unroll
    for (int kb = 0; kb < 2; ++kb)
#pragma unroll
      for (int e = 0; e < 16; ++e) mx = fmaxf(mx, Sx[kb][e]);
    mx = fmaxf(mx, __shfl_xor(mx, 32, 64));
    const float mnew = fmaxf(m, mx);
    const float scale = __expf(m - mnew);
    m = mnew;
    float ps = 0.f;
#pragma unroll
    for (int kb = 0; kb < 2; ++kb)
#pragma unroll
      for (int e = 0; e < 16; ++e) {
        float pv = __expf(Sx[kb][e] - mnew);
        Sx[kb][e] = pv;
        ps += pv;
      }
    lsum = lsum * scale + ps;
#pragma unroll
    for (int e = 0; e < 16; ++e) { O[0][e] *= scale; O[1][e] *= scale; }
#pragma unroll
    for (int kb = 0; kb < 2; ++kb)
#pragma unroll
      for (int s = 0; s < 2; ++s) {
        bf16x8 pfrag;
#pragma unroll
        for (int j = 0; j < 8; ++j) pfrag[j] = (short)f2bf(Sx[kb][8 * s + j]);
#pragma unroll
        for (int dt = 0; dt < 2; ++dt) {
          const bf16_t* vp = &sm->vt[(32 * dt + r) * 72 + 32 * kb + 16 * s + 4 * h];
          uint2 lo = *(const uint2*)vp, hi = *(const uint2*)(vp + 8);
          bf16x8 vf;
          uint4 tmp; tmp.x = lo.x; tmp.y = lo.y; tmp.z = hi.x; tmp.w = hi.y;
          vf = *(bf16x8*)&tmp;
          O[dt] = __builtin_amdgcn_mfma_f32_32x32x16_bf16(vf, pfrag, O[dt], 0, 0, 0);
        }
      }
  }
  const float ltot = lsum + __shfl_xor(lsum, 32, 64);
  const float invl = 1.f / ltot;
#pragma unroll
  for (int dt = 0; dt < 2; ++dt)
#pragma unroll
    for (int g = 0; g < 4; ++g) {
      uint2 v;
      v.x = pack2(O[dt][4 * g] * invl, O[dt][4 * g + 1] * invl);
      v.y = pack2(O[dt][4 * g + 2] * invl, O[dt][4 * g + 3] * invl);
      *(uint2*)(ATO + qrow * 256 + hq * 64 + 32 * dt + 8 * g + 4 * h) = v;
    }
}

DEV unsigned cu_key() {
  unsigned hw = __builtin_amdgcn_s_getreg((31 << 11) | (0 << 6) | 4);
  unsigned xcc = __builtin_amdgcn_s_getreg((3 << 11) | (0 << 6) | 20) & 0xFu;
  unsigned cu = (hw >> 8) & 0xFu, sh = (hw >> 12) & 1u, se = (hw >> 13) & 7u;
  return (xcc << 8) | (se << 5) | (sh << 4) | cu;
}

DEV void phase_scan(const P& p, int l, char* smem, int rep) {
  const int tid = opaque_tid();
  int* sch = (int*)(p.ws + OFF_SCH) + (l + 2 * rep) * 8448;
  int* cu_cnt = sch;
  int* cu_rank = sch + 4096;
  int* misc = sch + 8192;
  int* sh = (int*)(smem + SMEM_BYTES - 16);
  __syncthreads();
  if (tid == 0) {
    const unsigned key = cu_key();
    const int slot = atomicAdd(&cu_cnt[key], 1);
    int rank;
    if (slot == 0) {
      rank = atomicAdd(&misc[0], 1);
      atomicExch(&cu_rank[key], rank + 1);
    } else {
      while ((rank = atomicAdd(&cu_rank[key], 0)) == 0) __builtin_amdgcn_s_sleep(2);
      rank -= 1;
    }
    sh[1] = (rank < 256) ? (slot == 0 ? 0 : 1) : 2;
  }
  __syncthreads();
  const int role = sh[1];
  const int nA = (l == 0) ? 1152 : 1024;
  for (int stage = 0; stage < 3; ++stage) {
    int qsel;
    if (role == 0) qsel = (stage == 0) ? 0 : (stage == 1 ? 1 : 2);
    else qsel = (stage == 0) ? 1 : (stage == 1 ? 2 : 0);
    const int qn = (qsel == 0) ? 256 : (qsel == 1 ? 256 : nA);
    for (;;) {
      __syncthreads();
      if (tid == 0) sh[0] = atomicAdd(&misc[1 + qsel], 1);
      __syncthreads();
      const int t = sh[0];
      if (t >= qn) break;
      if (qsel == 0) scan_block<0, 8>(p, l, t, (float*)smem, tid);
      else if (qsel == 1) {
        if (t < 128) scan_block<1, 4>(p, l, t, (float*)smem, tid);
        else scan_block<2, 4>(p, l, t - 128, (float*)smem, tid);
      } else attn_task(p, l, t, (AttSmem*)smem, tid);
    }
  }
}

DEV void phase_post(const P& p, int l, char* smem) {
  const int tid = opaque_tid();
  const bf16_t* Y0 = (const bf16_t*)(p.ws + OFF_Y0);
  const bf16_t* Y1 = (const bf16_t*)((const char*)p.out + OUT_Y1);
  const bf16_t* Y2 = (const bf16_t*)((const char*)p.out + OUT_Y2);
  const bf16_t* ATO = (const bf16_t*)((const char*)p.out + OUT_ATO);
  const bf16_t* ZB = (const bf16_t*)(p.ws + OFF_ZB);
  const bf16_t* ZC = (const bf16_t*)(p.ws + OFF_ZC);
  const bf16_t* RWG = (const bf16_t*)(p.ws + OFF_RWG);
  const bf16_t* RWBG = RWG + RWSZ;
  bf16_t* BR = (bf16_t*)(p.ws + OFF_BR);
  const int nm = n_mrows(l);
  {
    const int lane = tid & 63, wv = tid >> 6, c8 = (lane & 31) * 8;
    float ga[8], gb[8];
#pragma unroll
    for (int j = 0; j < 8; ++j) { ga[j] = 1.f; gb[j] = 0.f; }
    if (wv == 0) { ld8f(p.in[16] + l * 256 + c8, ga); ld8f(p.in[17] + l * 256 + c8, gb); }
    else if (wv == 1) { ld8f(p.in[19] + l * 256 + c8, ga); ld8f(p.in[20] + l * 256 + c8, gb); }
    else if (wv == 2) { ld8f(p.in[22] + l * 256 + c8, ga); }
    const bf16_t* Ysrc = (wv == 0) ? Y0 : (wv == 1 ? Y1 : Y2);
#pragma unroll 2
    for (int pr = blockIdx.x; pr < nm / 2; pr += gridDim.x) {
      const int mrow = 2 * pr + (lane >> 5);
      const size_t row = map_row(l, mrow);
      uint4 outv;
      if (wv == 3) {
        outv = *(const uint4*)(ATO + row * 256 + c8);
      } else {
        float y0[8], y1[8], y[8], o[8];
        unpack8(*(const uint4*)(Ysrc + row * 256 + c8), y0);
        unpack8(*(const uint4*)(Ysrc + RWSZ + row * 256 + c8), y1);
        float sm = 0.f, sq = 0.f;
#pragma unroll
        for (int j = 0; j < 8; ++j) { y[j] = y0[j] + y1[j]; sm += y[j]; sq += y[j] * y[j]; }
        if (wv == 2) {
          const float ms = reduce8(sq) * (1.f / 64.f);
          const float rn = rsqrtf(ms + 1e-6f);
          float g[8];
          unpack8(*(const uint4*)(ZC + row * 1280 + 1024 + c8), g);
#pragma unroll
          for (int j = 0; j < 8; ++j) o[j] = y[j] * rn * ga[j] * siluf_(g[j]);
        } else {
          const float mean = reduce8(sm) * (1.f / 64.f);
          float vs = 0.f;
#pragma unroll
          for (int j = 0; j < 8; ++j) { y[j] -= mean; vs += y[j] * y[j]; }
          const float var = reduce8(vs) * (1.f / 64.f);
          const float rn = rsqrtf(var + (wv == 0 ? 64e-5f : 1e-5f));
          if (wv == 0) {
            float g[8], bg[8];
            unpack8(*(const uint4*)(RWG + row * 256 + c8), g);
            unpack8(*(const uint4*)(RWBG + row * 256 + c8), bg);
#pragma unroll
            for (int j = 0; j < 8; ++j) o[j] = (y[j] * rn * ga[j] + gb[j]) * g[j] + bg[j];
          } else {
            float g[8];
            unpack8(*(const uint4*)(ZB + row * 1024 + 768 + c8), g);
#pragma unroll
            for (int j = 0; j < 8; ++j) o[j] = (y[j] * rn * ga[j] + gb[j]) * siluf_(g[j]);
          }
        }
        outv = pack8(o);
      }
      *(uint4*)(BR + (size_t)mrow * 1024 + wv * 256 + c8) = outv;
    }
  }
  {
    const int n = tid * 4;
#pragma unroll 2
    for (int mrow = blockIdx.x; mrow < nm; mrow += gridDim.x) {
      const int row = map_row(l, mrow);
      const float4 x = *(const float4*)(xin_row(p, l, row) + n);
      const float* mr = mod_row(p, l, row);
      const float4 sh = *(const float4*)(mr + n), sc = *(const float4*)(mr + 1024 + n);
      uint2 o;
      o.x = pack2(x.x * (1.f + sc.x) + sh.x, x.y * (1.f + sc.y) + sh.y);
      o.y = pack2(x.z * (1.f + sc.z) + sh.z, x.w * (1.f + sc.w) + sh.w);
      *(uint2*)(u2_row(p, row) + n) = o;
    }
  }
  conv_batch(p.in[25] + (size_t)l * 4 * 1024 * 1024, (bf16_t*)(p.ws + OFF_WGT), 1024, 1024, 4, (float*)smem, tid);
  conv_batch(p.in[26] + (size_t)l * 4 * 256 * 1024, (bf16_t*)(p.ws + OFF_WBT), 256, 1024, 4, (float*)smem, tid);
  conv_batch(p.in[27] + (size_t)l * 1024 * 1024, (bf16_t*)(p.ws + OFF_WOT), 1024, 1024, 1, (float*)smem, tid);
}

DEV void phase_merge(const P& p, int l, char* smem) {
  GemmSmem* sm = (GemmSmem*)smem;
  ACC_IDS
  {
    int* tc = (int*)(p.ws + OFF_TCNT);
    for (int i = blockIdx.x * 256 + tid; i < ROWS_; i += gridDim.x * 256) tc[i] = 0;
  }
  const bf16_t* BR = (const bf16_t*)(p.ws + OFF_BR);
  bf16_t* MRG = (bf16_t*)(p.ws + OFF_MRG);
  int mt, nt;
  unsigned* lds32 = (unsigned*)smem;
  for (int it = 0; tile_map(it, n_mrows(l) / 128, 8, mt, nt); ++it) {
    f32x16 mer[2][2];
#pragma unroll
    for (int mi = 0; mi < 2; ++mi)
#pragma unroll
      for (int ni = 0; ni < 2; ++ni)
#pragma unroll
        for (int e = 0; e < 16; ++e) mer[mi][ni][e] = 0.f;
    ALBf au, ab;
#pragma unroll
    for (int q = 0; q < 2; ++q) {
      const int mrow = mt * 128 + (tid >> 2) + 64 * q;
      au.ap[q] = u2_row(p, map_row(l, mrow));
      ab.ap[q] = BR + (size_t)mrow * 1024;
    }
    for (int i = 0; i < 4; ++i) {
      {
        f32x16 abr[1][2][2];
        acc_zero<1, 2>(abr);
        ALBf abi = ab;
        abi.ap[0] += i * 256;
        abi.ap[1] += i * 256;
        gemm_core<1, 2>(abi, (const bf16_t*)(p.ws + OFF_WBT) + ((size_t)(i * 1024 + nt * 128)) * 256, nullptr, 256, 256, sm, abr, tid);
#pragma unroll
        for (int mi = 0; mi < 2; ++mi)
#pragma unroll
          for (int ni = 0; ni < 2; ++ni)
#pragma unroll
            for (int e = 0; e < 8; ++e) {
              const int j = (mi * 2 + ni) * 8 + e;
              const int word = (j < 10) ? (7680 + j * 256) : (j < 20 ? (12800 + (j - 10) * 256) : (15360 + (j - 20) * 256));
              lds32[word + tid] = pack2(abr[0][mi][ni][2 * e], abr[0][mi][ni][2 * e + 1]);
            }
      }
      f32x16 ag[1][2][2];
      acc_zero<1, 2>(ag);
      gemm_core<1, 2>(au, (const bf16_t*)(p.ws + OFF_WGT) + ((size_t)(i * 1024 + nt * 128)) * 1024, nullptr, 1024, 1024, sm, ag, tid);
#pragma unroll
      for (int mi = 0; mi < 2; ++mi)
#pragma unroll
        for (int ni = 0; ni < 2; ++ni)
#pragma unroll
          for (int e = 0; e < 8; ++e) {
            const int j = (mi * 2 + ni) * 8 + e;
            const int word = (j < 10) ? (7680 + j * 256) : (j < 20 ? (12800 + (j - 10) * 256) : (15360 + (j - 20) * 256));
            const unsigned bp = lds32[word + tid];
            mer[mi][ni][2 * e] += sigmoidf_(ag[0][mi][ni][2 * e]) * __uint_as_float(bp << 16);
            mer[mi][ni][2 * e + 1] += sigmoidf_(ag[0][mi][ni][2 * e + 1]) * __uint_as_float(bp & 0xFFFF0000u);
          }
    }
#pragma unroll
    for (int mi = 0; mi < 2; ++mi)
#pragma unroll
      for (int ni = 0; ni < 2; ++ni)
#pragma unroll
        for (int e = 0; e < 16; e += 2)
          store_rowpair_bf16(MRG, 1024, mt * 128 + ACC_ROW(mi, e), nt * 128 + ACC_COL(ni), mer[mi][ni][e], mer[mi][ni][e + 1]);
  }
}

DEV void phase_out(const P& p, int l, char* smem) {
  GemmSmem* sm = (GemmSmem*)smem;
  ACC_IDS
  const bf16_t* MRG = (const bf16_t*)(p.ws + OFF_MRG);
  float* XA = (float*)(p.ws + OFF_XA);
  int mt, nt;
  for (int it = 0; tile_map(it, n_mrows(l) / 128, 8, mt, nt); ++it) {
    const bf16_t* apm[4];
#pragma unroll
    for (int q = 0; q < 4; ++q) apm[q] = MRG + (size_t)(mt * 128 + (tid >> 3) + 32 * q) * 1024;
    f32x16 acc[1][2][2];
    acc_zero<1, 2>(acc);
    gemm64<2>(apm, (const bf16_t*)(p.ws + OFF_WOT) + (size_t)(nt * 128) * 1024, 1024, 1024, (GemmSmem64*)smem, acc, tid);
#pragma unroll
    for (int mi = 0; mi < 2; ++mi)
#pragma unroll
      for (int e = 0; e < 16; ++e) {
        const int mrow = mt * 128 + ACC_ROW(mi, e);
        const int row = map_row(l, mrow);
        const float* xr = xin_row(p, l, row);
        const float* mr = mod_row(p, l, row);
#pragma unroll
        for (int ni = 0; ni < 2; ++ni) {
          int col = nt * 128 + ACC_COL(ni);
          XA[(size_t)row * D_ + col] = ALPHA * xr[col] + mr[2048 + col] * acc[0][mi][ni][e];
        }
      }
  }
}

DEV float block_sum(float v, float* red, const int tid) {
  v = wave_sum(v);
  __syncthreads();
  if ((tid & 63) == 0) red[tid >> 6] = v;
  __syncthreads();
  return (red[0] + red[1]) + (red[2] + red[3]);
}

DEV void phase_ln1(const P& p, int l, char* smem) {
  float* u2s = (float*)smem;
  float* part = u2s + 4096;
  const int tid = opaque_tid(), lane = tid & 63, wv = tid >> 6;
  float* XA = (float*)(p.ws + OFF_XA);
  float* AFF = (float*)(p.ws + OFF_AFF);
  const float* lng = p.in[28] + l * 1024;
  const float* lnb = p.in[29] + l * 1024;
  const int re = tid & 15, ng = tid >> 4;
  float wr[64];
  {
    const float* WR = p.in[30] + (size_t)l * 1024 * 16;
#pragma unroll
    for (int j = 0; j < 64; ++j) wr[j] = WR[(size_t)(ng * 64 + j) * 16 + re];
  }
  const int nm = n_mrows(l);
  for (int grp = blockIdx.x; grp < nm / 4; grp += gridDim.x) {
    const int mrow = grp * 4 + wv;
    const int row = map_row(l, mrow);
    const float* mr = mod_row(p, l, row);
    float4 v[4];
    float sm = 0.f;
#pragma unroll
    for (int i = 0; i < 4; ++i) {
      v[i] = *(const float4*)(XA + (size_t)row * D_ + 4 * lane + 256 * i);
      sm += (v[i].x + v[i].y) + (v[i].z + v[i].w);
    }
    const float mean = wave_sum(sm) * (1.f / 1024.f);
    float vs = 0.f;
#pragma unroll
    for (int i = 0; i < 4; ++i) {
      v[i].x -= mean; v[i].y -= mean; v[i].z -= mean; v[i].w -= mean;
      vs += (v[i].x * v[i].x + v[i].y * v[i].y) + (v[i].z * v[i].z + v[i].w * v[i].w);
    }
    const float rs = rsqrtf(wave_sum(vs) * (1.f / 1024.f) + 1e-5f);
#pragma unroll
    for (int i = 0; i < 4; ++i) {
      const int n = 4 * lane + 256 * i;
      const float4 gq = *(const float4*)(lng + n), bq = *(const float4*)(lnb + n);
      const float4 x1 = make_float4(v[i].x * rs * gq.x + bq.x, v[i].y * rs * gq.y + bq.y,
                                    v[i].z * rs * gq.z + bq.z, v[i].w * rs * gq.w + bq.w);
      *(float4*)(XA + (size_t)row * D_ + n) = x1;
      const float4 sh = *(const float4*)(mr + 3072 + n), scv = *(const float4*)(mr + 4096 + n);
      const float4 um = make_float4(x1.x * (1.f + scv.x) + sh.x, x1.y * (1.f + scv.y) + sh.y,
                                    x1.z * (1.f + scv.z) + sh.z, x1.w * (1.f + scv.w) + sh.w);
      *(float4*)(u2s + wv * 1024 + n) = um;
      uint2 ub;
      ub.x = pack2(um.x, um.y);
      ub.y = pack2(um.z, um.w);
      *(uint2*)((bf16_t*)(p.ws + OFF_XS) + (size_t)row * D_ + n) = ub;
    }
    __syncthreads();
    float acc[4] = {0.f, 0.f, 0.f, 0.f};
#pragma unroll
    for (int j4 = 0; j4 < 16; ++j4) {
#pragma unroll
      for (int rw = 0; rw < 4; ++rw) {
        const float4 u = *(const float4*)(u2s + rw * 1024 + ng * 64 + 4 * j4);
        acc[rw] += u.x * wr[4 * j4] + u.y * wr[4 * j4 + 1] + u.z * wr[4 * j4 + 2] + u.w * wr[4 * j4 + 3];
      }
    }
#pragma unroll
    for (int rw = 0; rw < 4; ++rw) part[(ng * 4 + rw) * 16 + re] = acc[rw];
    __syncthreads();
    if (tid < 64) {
      const int rw = tid >> 4;
      float lg = 0.f;
#pragma unroll
      for (int g = 0; g < 16; ++g) lg += part[(g * 4 + rw) * 16 + re];
      float mx = lg;
#pragma unroll
      for (int o = 8; o > 0; o >>= 1) mx = fmaxf(mx, __shfl_xor(mx, o, 16));
      const float ex = __expf(lg - mx);
      const float den = reduce16(ex);
      const int r2 = map_row(l, grp * 4 + rw);
      const int b = r2 / T_, t = r2 - b * T_;
      AFF[((size_t)(b * 16 + re)) * T_ + t] = ex / den;
    }
  }
  conv_batch(p.in[31] + (size_t)l * 16 * 1024 * 1024, (bf16_t*)(p.ws + OFF_WE1T), 1024, 1024, 16, (float*)smem, tid);
  conv_batch(p.in[32] + (size_t)l * 16 * 1024 * 1024, (bf16_t*)(p.ws + OFF_WE3T), 1024, 1024, 16, (float*)smem, tid);
  conv_batch(p.in[33] + (size_t)l * 16 * 1024 * 1024, (bf16_t*)(p.ws + OFF_WE2T), 1024, 1024, 16, (float*)smem, tid);
}

DEV void phase_topk(const P& p, int l, char* smem) {
  u64* keys = (u64*)smem;
  const int tid = opaque_tid();
  const float* AFF = (const float*)(p.ws + OFF_AFF);
  int* IDX = (int*)(p.ws + OFF_IDX);
  float* GATE = (float*)(p.ws + OFF_GATE);
  const int ntask = (l == 0) ? 512 : 256;
  for (int task = blockIdx.x; task < ntask; task += gridDim.x) {
    const int seg = task >> 8, be = task & 255;
    const int n = seg ? NC_ : NL_, t0 = seg ? 0 : NC_, cap = seg ? 32 : 256;
    const float* aff = AFF + (size_t)be * T_ + t0;
    __syncthreads();
    for (int i = tid; i < 2048; i += 256)
      keys[i] = (i < n) ? (((u64)__float_as_uint(aff[i]) << 32) | (u64)(0xFFFFFFFFu - (unsigned)i)) : 0ull;
    __syncthreads();
    for (int k = 2; k <= 2048; k <<= 1)
      for (int j = k >> 1; j > 0; j >>= 1) {
        for (int i = tid; i < 2048; i += 256) {
          int ixj = i ^ j;
          if (ixj > i) {
            u64 a = keys[i], bb = keys[ixj];
            bool desc = ((i & k) == 0);
            if (desc ? (a < bb) : (a > bb)) { keys[i] = bb; keys[ixj] = a; }
          }
        }
        __syncthreads();
      }
    for (int i = tid; i < cap; i += 256) {
      u64 kv = keys[i];
      IDX[be * 288 + seg * 256 + i] = (int)(0xFFFFFFFFu - (unsigned)(kv & 0xFFFFFFFFull));
      GATE[be * 288 + seg * 256 + i] = __uint_as_float((unsigned)(kv >> 32));
      {
        const int bb = be >> 4, ee = be & 15;
        const int tok = (int)(0xFFFFFFFFu - (unsigned)(kv & 0xFFFFFFFFull));
        const int grow = bb * T_ + t0 + tok;
        const int slot = seg ? (bb * 32 + i) : (bb * 256 + i);
        const int yrow = (ee * 36 + (seg ? 32 : 0) + (slot >> 7)) * 128 + (slot & 127);
        const int pos = atomicAdd((int*)(p.ws + OFF_TCNT) + grow, 1);
        uint2 ent;
        ent.x = (unsigned)yrow;
        ent.y = (unsigned)(kv >> 32);
        ((uint2*)(p.ws + OFF_TLIST))[(size_t)grow * 16 + (pos & 15)] = ent;
      }
    }
  }
}

DEV void slot_info(const P& p, int e, int mtile, int rr, int& row, float& gate, int& seg, int& b, int& idx) {
  const int* IDX = (const int*)(p.ws + OFF_IDX);
  const float* GATE = (const float*)(p.ws + OFF_GATE);
  if (mtile < 32) {
    int slot = mtile * 128 + rr;
    b = slot >> 8;
    int j = slot & 255;
    idx = IDX[(b * 16 + e) * 288 + j];
    gate = GATE[(b * 16 + e) * 288 + j];
    seg = 0;
    row = b * T_ + NC_ + idx;
  } else {
    int slot = (mtile - 32) * 128 + rr;
    b = slot >> 5;
    int j = slot & 31;
    idx = IDX[(b * 16 + e) * 288 + 256 + j];
    gate = GATE[(b * 16 + e) * 288 + 256 + j];
    seg = 1;
    row = b * T_ + idx;
  }
}

DEV void phase_eup(const P& p, int l, char* smem) {
  GemmSmem* sm = (GemmSmem*)smem;
  ACC_IDS
  const float* XA = (const float*)(p.ws + OFF_XA);
  bf16_t* H = (bf16_t*)(p.ws + OFF_H);
  const int MT = (l == 0) ? 36 : 32;
  int em, nt;
  for (int it = 0; tile_map(it, 16 * MT, 8, em, nt); ++it) {
    const int mt = em % MT, e = em / MT;
    ALBfIdx al;
    al.base = (const bf16_t*)(p.ws + OFF_XS);
#pragma unroll
    for (int q = 0; q < 2; ++q) {
      int row, seg, b, idx;
      float gate;
      slot_info(p, e, mt, (tid >> 2) + 64 * q, row, gate, seg, b, idx);
      al.off[q] = (unsigned)row * (unsigned)D_;
    }
    f32x16 acc[2][2][2];
    acc_zero<2, 2>(acc);
    const size_t wo = ((size_t)(e * 1024 + nt * 128)) * 1024;
    gemm_core<2, 2>(al, (const bf16_t*)(p.ws + OFF_WE1T) + wo, (const bf16_t*)(p.ws + OFF_WE3T) + wo, 1024, 1024, sm, acc, tid);
#pragma unroll
    for (int mi = 0; mi < 2; ++mi)
#pragma unroll
      for (int ni = 0; ni < 2; ++ni)
#pragma unroll
        for (int q = 0; q < 16; q += 2)
          store_rowpair_bf16(H, 1024, (e * 36 + mt) * 128 + ACC_ROW(mi, q), nt * 128 + ACC_COL(ni),
                             siluf_(acc[0][mi][ni][q]) * acc[1][mi][ni][q], siluf_(acc[0][mi][ni][q + 1]) * acc[1][mi][ni][q + 1]);
  }
}

DEV void phase_edown(const P& p, int l, char* smem) {
  ACC_IDS
  const bf16_t* H = (const bf16_t*)(p.ws + OFF_H);
  bf16_t* YE = (bf16_t*)(p.ws + OFF_YEXP);
  const int MT = (l == 0) ? 36 : 32;
  int em, nt;
  for (int it = 0; tile_map(it, 16 * MT, 8, em, nt); ++it) {
    const int mt = em % MT, e = em / MT;
    const bf16_t* aph[4];
#pragma unroll
    for (int q = 0; q < 4; ++q) aph[q] = H + (size_t)((e * 36 + mt) * 128 + (tid >> 3) + 32 * q) * 1024;
    f32x16 acc[1][2][2];
    acc_zero<1, 2>(acc);
    gemm64<2>(aph, (const bf16_t*)(p.ws + OFF_WE2T) + ((size_t)(e * 1024 + nt * 128)) * 1024, 1024, 1024, (GemmSmem64*)smem, acc, tid);
#pragma unroll
    for (int mi = 0; mi < 2; ++mi)
#pragma unroll
      for (int ni = 0; ni < 2; ++ni)
#pragma unroll
        for (int q = 0; q < 16; q += 2)
          store_rowpair_bf16(YE, 1024, (e * 36 + mt) * 128 + ACC_ROW(mi, q), nt * 128 + ACC_COL(ni), acc[0][mi][ni][q], acc[0][mi][ni][q + 1]);
  }
}

DEV void phase_ln2(const P& p, int l, char* smem) {
  const int tid = opaque_tid(), lane = tid & 63, wv = tid >> 6;
  float* XA = (float*)(p.ws + OFF_XA);
  const bf16_t* YE = (const bf16_t*)(p.ws + OFF_YEXP);
  const int* TC = (const int*)(p.ws + OFF_TCNT);
  const uint2* TL = (const uint2*)(p.ws + OFF_TLIST);
  float4 g4[4], b4[4];
#pragma unroll
  for (int i = 0; i < 4; ++i) {
    g4[i] = *(const float4*)(p.in[34] + l * 1024 + 4 * lane + 256 * i);
    b4[i] = *(const float4*)(p.in[35] + l * 1024 + 4 * lane + 256 * i);
  }
  const int nm = n_mrows(l);
#pragma unroll 2
  for (int mrow = blockIdx.x * 4 + wv; mrow < nm; mrow += gridDim.x * 4) {
    const int row = map_row(l, mrow);
    const int b = row / T_, t = row - b * T_;
    const float* mr = mod_row(p, l, row);
    float4 f[4];
#pragma unroll
    for (int i = 0; i < 4; ++i) f[i] = make_float4(0.f, 0.f, 0.f, 0.f);
    const int nc = min(TC[row], 16);
    uint2 ent4[4];
#pragma unroll
    for (int k = 0; k < 4; ++k) ent4[k] = TL[(size_t)row * 16 + k];
    auto add_contrib = [&](const uint2 ent) __attribute__((always_inline)) {
      const float gate = __uint_as_float(ent.y);
      const bf16_t* yr = YE + (size_t)ent.x * 1024;
#pragma unroll
      for (int i = 0; i < 4; ++i) {
        const uint2 yv = *(const uint2*)(yr + 4 * lane + 256 * i);
        f[i].x += gate * __uint_as_float(yv.x << 16);
        f[i].y += gate * __uint_as_float(yv.x & 0xFFFF0000u);
        f[i].z += gate * __uint_as_float(yv.y << 16);
        f[i].w += gate * __uint_as_float(yv.y & 0xFFFF0000u);
      }
    };
#pragma unroll
    for (int k = 0; k < 4; ++k)
      if (k < nc) add_contrib(ent4[k]);
    for (int k = 4; k < nc; ++k) add_contrib(TL[(size_t)row * 16 + k]);
    float4 v[4];
    float sm = 0.f;
#pragma unroll
    for (int i = 0; i < 4; ++i) {
      const int n = 4 * lane + 256 * i;
      const float4 x1 = *(const float4*)(XA + (size_t)row * D_ + n);
      const float4 g2 = *(const float4*)(mr + 5120 + n);
      v[i] = make_float4(ALPHA * x1.x + g2.x * f[i].x, ALPHA * x1.y + g2.y * f[i].y, ALPHA * x1.z + g2.z * f[i].z,
                         ALPHA * x1.w + g2.w * f[i].w);
      sm += (v[i].x + v[i].y) + (v[i].z + v[i].w);
    }
    const float mean = wave_sum(sm) * (1.f / 1024.f);
    float vs = 0.f;
#pragma unroll
    for (int i = 0; i < 4; ++i) {
      v[i].x -= mean; v[i].y -= mean; v[i].z -= mean; v[i].w -= mean;
      vs += (v[i].x * v[i].x + v[i].y * v[i].y) + (v[i].z * v[i].z + v[i].w * v[i].w);
    }
    const float rs = rsqrtf(wave_sum(vs) * (1.f / 1024.f) + 1e-5f);
    float* orow = p.out + ((size_t)(b * NL_ + t - NC_)) * D_;
#pragma unroll
    for (int i = 0; i < 4; ++i) {
      const int n = 4 * lane + 256 * i;
      const float4 o = make_float4(v[i].x * rs * g4[i].x + b4[i].x, v[i].y * rs * g4[i].y + b4[i].y,
                                   v[i].z * rs * g4[i].z + b4[i].z, v[i].w * rs * g4[i].w + b4[i].w);
      if (l == 0) {
        *(float4*)(XA + (size_t)row * D_ + n) = o;
        write_u_row(p, 1, row, o, n);
      } else *(float4*)(orow + n) = o;
    }
  }
  if (l == 0) conv_batch(p.in[6] + (size_t)1024 * 3968, (bf16_t*)(p.ws + OFF_WINT1), 1024, 3968, 1, (float*)smem, tid);
}

constexpr int NPHASE = 23;
DEV void run_phase(const P& p, int ph, char* smem) {
  if (ph == 0) { phase_mod(p, smem); return; }
  const int l = (ph - 1) / 11, k = (ph - 1) % 11;
  switch (k) {
    case 0: phase_in(p, l, smem); break;
    case 1: phase_prep(p, l, smem); break;
    case 2: phase_scan(p, l, smem, 0); break;
    case 3: phase_post(p, l, smem); break;
    case 4: phase_merge(p, l, smem); break;
    case 5: phase_out(p, l, smem); break;
    case 6: phase_ln1(p, l, smem); break;
    case 7: phase_topk(p, l, smem); break;
    case 8: phase_eup(p, l, smem); break;
    case 9: phase_edown(p, l, smem); break;
    default: phase_ln2(p, l, smem); break;
  }
}

#define XB_TMO      128
#define XB_XCNT(j)  (256  + 64 * (j))
#define XB_XSUB(j)  (1280 + 64 * (j))
#define XB_XGEN(j)  (2304 + 64 * (j))
#define XB_TOP      3328
#define XB_TOPGEN   3392
#define XCD_BAR_WORDS 3456
#define XB_SPIN_CAP (1u << 22)
#define LAS __attribute__((address_space(3)))
DEV unsigned xb_ld(unsigned* p) { return __hip_atomic_load(p, __ATOMIC_RELAXED, __HIP_MEMORY_SCOPE_AGENT); }
DEV unsigned xb_add(unsigned* p, unsigned v) { return __hip_atomic_fetch_add(p, v, __ATOMIC_RELAXED, __HIP_MEMORY_SCOPE_AGENT); }
DEV unsigned xb_xcc_id() { return (unsigned)__builtin_amdgcn_s_getreg((3 << 11) | 20) & 0xFu; }
#define XB_SPIN(cond, bar) do { unsigned _sp = 0; while (cond) { __builtin_amdgcn_s_sleep(1); \
    if ((++_sp & 255u) == 0u) { if (xb_ld(&(bar)[XB_TMO])) break; if (_sp > XB_SPIN_CAP) { atomicAdd(&(bar)[XB_TMO], 1u); break; } } } } while (0)
struct XcdBarrier {
  unsigned* bar;
  unsigned x;
  volatile LAS unsigned* st;
};
DEV XcdBarrier xcd_barrier_post(unsigned* bar, volatile LAS unsigned* st) {
  XcdBarrier b; b.bar = bar; b.x = xb_xcc_id(); b.st = st;
  if (threadIdx.x == 0) (void)xb_add(&bar[XB_XCNT(b.x)], 1u);
  return b;
}
DEV void xcd_barrier_complete(unsigned* bar, unsigned x, unsigned& nloc, unsigned& nx) {
  const unsigned G = gridDim.x * gridDim.y * gridDim.z;
  unsigned sum, cnt, mine, sp = 0u;
  for (;;) {
    sum = 0u; cnt = 0u; mine = 0u;
#pragma unroll
    for (unsigned j = 0; j < 16; ++j) { const unsigned c = xb_ld(&bar[XB_XCNT(j)]); sum += c; cnt += (c > 0u) ? 1u : 0u; mine = (j == x) ? c : mine; }
    if (sum == G) break;
    __builtin_amdgcn_s_sleep(1);
    if ((++sp & 255u) == 0u) { if (xb_ld(&bar[XB_TMO])) break; if (sp > XB_SPIN_CAP) { atomicAdd(&bar[XB_TMO], 1u); break; } }
  }
  nloc = mine > 0u ? mine : 1u; nx = cnt > 0u ? cnt : 1u;
}
DEV void xcd_barrier(const XcdBarrier& b) {
  asm volatile("s_waitcnt vmcnt(0)" ::: "memory");
  __syncthreads();
  if (threadIdx.x == 0) {
    unsigned* bar = b.bar;
    __builtin_amdgcn_s_waitcnt(0);
    unsigned nloc = b.st[0], nx = b.st[1];
    if (nloc == 0u) { xcd_barrier_complete(bar, b.x, nloc, nx); b.st[0] = nloc; b.st[1] = nx; }
    const unsigned old = xb_add(&bar[XB_XSUB(b.x)], 1u);
    const unsigned gen = old / nloc;
    if (old + 1u == (gen + 1u) * nloc) {
      __builtin_amdgcn_fence(__ATOMIC_RELEASE, "agent");
      asm volatile("s_waitcnt vmcnt(0)" ::: "memory");
      const unsigned og = xb_add(&bar[XB_TOP], 1u);
      const unsigned tg = og / nx;
      if (og + 1u == (tg + 1u) * nx) xb_add(&bar[XB_TOPGEN], 1u);
      else XB_SPIN(xb_ld(&bar[XB_TOPGEN]) == tg, bar);
      __builtin_amdgcn_fence(__ATOMIC_ACQUIRE, "agent");
      xb_add(&bar[XB_XGEN(b.x)], 1u);
      asm volatile("s_waitcnt vmcnt(0)" ::: "memory");
    } else {
      XB_SPIN(xb_ld(&bar[XB_XGEN(b.x)]) == gen, bar);
      __builtin_amdgcn_fence(__ATOMIC_ACQUIRE, "agent");
      asm volatile("s_waitcnt vmcnt(0)" ::: "memory");
    }
  }
  __syncthreads();
}

#ifndef REPMASK
#define REPMASK 0
#endif
template <int L>
DEV void run_layer(const P& p, char* smem, const XcdBarrier& xb) {
  phase_in(p, L, smem);
  xcd_barrier(xb);
  if (REPMASK & (1 << 0)) { phase_in(p, L, smem); xcd_barrier(xb); }
  phase_prep(p, L, smem);
  xcd_barrier(xb);
  phase_prep2(p, L, smem);
  xcd_barrier(xb);
  if (REPMASK & (1 << 1)) { phase_prep(p, L, smem); xcd_barrier(xb); phase_prep2(p, L, smem); xcd_barrier(xb); }
  phase_scan(p, L, smem, 0);
  xcd_barrier(xb);
  if (REPMASK & (1 << 2)) { phase_scan(p, L, smem, 1); xcd_barrier(xb); }
  phase_post(p, L, smem);
  xcd_barrier(xb);
  if (REPMASK & (1 << 3)) { phase_post(p, L, smem); xcd_barrier(xb); }
  phase_merge(p, L, smem);
  xcd_barrier(xb);
  if (REPMASK & (1 << 4)) { phase_merge(p, L, smem); xcd_barrier(xb); }
  phase_out(p, L, smem);
  xcd_barrier(xb);
  if (REPMASK & (1 << 5)) { phase_out(p, L, smem); xcd_barrier(xb); }
  phase_ln1(p, L, smem);
  xcd_barrier(xb);
  if (REPMASK & (1 << 6)) { phase_ln1(p, L, smem); xcd_barrier(xb); }
  phase_topk(p, L, smem);
  xcd_barrier(xb);
  if (REPMASK & (1 << 7)) { phase_topk(p, L, smem); xcd_barrier(xb); }
  phase_eup(p, L, smem);
  xcd_barrier(xb);
  if (REPMASK & (1 << 8)) { phase_eup(p, L, smem); xcd_barrier(xb); }
  phase_edown(p, L, smem);
  xcd_barrier(xb);
  if (REPMASK & (1 << 9)) { phase_edown(p, L, smem); xcd_barrier(xb); }
  phase_ln2(p, L, smem);
}

__global__ void __launch_bounds__(256, 2) mega(P p) {
  __shared__ __attribute__((aligned(16))) char smem[SMEM_BYTES];
  __shared__ uint4 xb_words;
  cg::grid_group grid = cg::this_grid();
  if (threadIdx.x == 0) xb_words = make_uint4(0u, 0u, 0u, 0u);
  __syncthreads();
  XcdBarrier xb = xcd_barrier_post((unsigned*)(p.ws + OFF_BAR), (volatile LAS unsigned*)&xb_words);
  phase_mod(p, smem);
  if (p.ws == nullptr) grid.sync();
  xcd_barrier(xb);
  phase_u(p, smem);
  xcd_barrier(xb);
  run_layer<0>(p, smem, xb);
  xcd_barrier(xb);
  run_layer<1>(p, smem, xb);
}

#ifdef MULTI_LAUNCH
template <int K>
__global__ void __launch_bounds__(256) phase_kernel(P p, int l) {
  __shared__ __attribute__((aligned(16))) char smem[SMEM_BYTES];
  if (K == -1) phase_mod(p, smem);
  if (K == 0) phase_in(p, l, smem);
  if (K == 1) phase_prep(p, l, smem);
  if (K == 2) phase_scan(p, l, smem, 0);
  if (K == 3) phase_post(p, l, smem);
  if (K == 4) phase_merge(p, l, smem);
  if (K == 5) phase_out(p, l, smem);
  if (K == 6) phase_ln1(p, l, smem);
  if (K == 7) phase_topk(p, l, smem);
  if (K == 8) phase_eup(p, l, smem);
  if (K == 9) phase_edown(p, l, smem);
  if (K == 10) phase_ln2(p, l, smem);
}
#endif

extern "C" void kernel_launch(void* const* d_in, const int* in_sizes, int n_in, void* d_out, int out_size,
                              void* d_ws, size_t ws_size, hipStream_t stream) {
  static int grid_blocks = 0;
  if (!grid_blocks) {
    int dev = 0, cus = 0, per_cu = 0;
    hipGetDevice(&dev);
    hipDeviceGetAttribute(&cus, hipDeviceAttributeMultiprocessorCount, dev);
    hipOccupancyMaxActiveBlocksPerMultiprocessor(&per_cu, mega, 256, 0);
    if (per_cu > 2) per_cu = 2;
    if (per_cu < 1) per_cu = 1;
    grid_blocks = cus * per_cu;
  }
  P p{};
  for (int i = 0; i < 36; ++i) p.in[i] = (const float*)d_in[i];
  p.out = (float*)d_out;
  p.ws = (char*)d_ws;
  if (ws_size < WS_NEED) fprintf(stderr, "workspace too small: %zu < %zu\n", ws_size, WS_NEED);
#ifdef MULTI_LAUNCH
  const dim3 g(grid_blocks), bk(256);
  hipLaunchKernelGGL(phase_kernel<-1>, g, bk, 0, stream, p, 0);
  for (int l = 0; l < 2; ++l) {
    hipLaunchKernelGGL(phase_kernel<0>, g, bk, 0, stream, p, l);
    hipLaunchKernelGGL(phase_kernel<1>, g, bk, 0, stream, p, l);
    hipLaunchKernelGGL(phase_kernel<2>, g, bk, 0, stream, p, l);
    hipLaunchKernelGGL(phase_kernel<3>, g, bk, 0, stream, p, l);
    hipLaunchKernelGGL(phase_kernel<4>, g, bk, 0, stream, p, l);
    hipLaunchKernelGGL(phase_kernel<5>, g, bk, 0, stream, p, l);
    hipLaunchKernelGGL(phase_kernel<6>, g, bk, 0, stream, p, l);
    hipLaunchKernelGGL(phase_kernel<7>, g, bk, 0, stream, p, l);
    hipLaunchKernelGGL(phase_kernel<8>, g, bk, 0, stream, p, l);
    hipLaunchKernelGGL(phase_kernel<9>, g, bk, 0, stream, p, l);
    hipLaunchKernelGGL(phase_kernel<10>, g, bk, 0, stream, p, l);
  }
#else
  hipMemsetAsync((char*)d_ws + OFF_BAR, 0, XCD_BAR_WORDS * 4, stream);
  void* args[] = {&p};
  hipError_t e = hipLaunchCooperativeKernel((void*)mega, dim3(grid_blocks), dim3(256), args, 0, stream);
  if (e != hipSuccess) fprintf(stderr, "cooperative launch failed: %s (grid %d)\n", hipGetErrorString(e), grid_blocks);
#endif
}
```
